# Optimizing an MI355X kernel written in HIP

```python
import jax, jax.numpy as jnp
from jax import lax
import numpy as np

D_MODEL = 1024
BATCH = 4
SEQ = 8192
DEPTH = 4

CTX_LEN = 256
GRID_W = 64

NA_HEADS = D_MODEL // 128
HEAD_DIM = 64
NA_WIDTH = NA_HEADS * HEAD_DIM
NA_KH = 8
NA_KW = 16
ROPE_AXIS_DIM = HEAD_DIM // 2
ROPE_THETA = 10000.0
POOL_WIDTH = D_MODEL // 4
POOL_GROUPS = 4
POOL_GROUP_DIM = POOL_WIDTH // POOL_GROUPS
POOL_WINDOWS = (2, 4, 8, 16)
FOURIER_WIDTH = D_MODEL // 4
FOURIER_GROUPS = 4
FOURIER_GROUP_DIM = FOURIER_WIDTH // FOURIER_GROUPS
CONV_WIDTH = D_MODEL // 4
CONV_K = 31
N_BRANCH = 4
D_FF = 4 * D_MODEL
EPS = 1e-6

Q_OFF = 0
K_OFF = NA_WIDTH
V_OFF = 2 * NA_WIDTH
POOL_OFF = 3 * NA_WIDTH
FOUR_OFF = POOL_OFF + POOL_WIDTH
CONV_OFF = FOUR_OFF + FOURIER_WIDTH
GATE_OFF = CONV_OFF + 2 * CONV_WIDTH
IN_WIDTH = GATE_OFF + N_BRANCH * D_MODEL

kernel_name = "hybrid_na_pool_fourier_conv_dit"


def rmsnorm(x, g):
    xf = x.astype(jnp.float32)
    y = xf * lax.rsqrt(jnp.mean(xf * xf, axis=-1, keepdims=True) + EPS)
    return (y * g.astype(jnp.float32)).astype(x.dtype)


def ada(cvec, w_mod, b_mod, n_chunks):
    m = jax.nn.silu(cvec) @ w_mod[:, :n_chunks * D_MODEL] + b_mod[:n_chunks * D_MODEL]
    m = m[..., None, :]
    return jnp.split(m, n_chunks, axis=-1)


def modulate(h, shift, scale):
    return h * (1.0 + scale) + shift


def split_qkv(p):
    hs = p.shape[:-1] + (NA_HEADS, HEAD_DIM)
    return (p[..., Q_OFF:K_OFF].reshape(hs), p[..., K_OFF:V_OFF].reshape(hs), p[..., V_OFF:POOL_OFF].reshape(hs))


def axial_rope_tables(n, dtype):
    t = jnp.arange(n)
    row = (t // GRID_W).astype(jnp.float32)
    col = (t % GRID_W).astype(jnp.float32)
    inv = ROPE_THETA ** (-jnp.arange(0, ROPE_AXIS_DIM, 2, dtype=jnp.float32) / ROPE_AXIS_DIM)
    ang = jnp.concatenate([row[:, None] * inv, col[:, None] * inv], axis=-1)
    return jnp.cos(ang).astype(dtype), jnp.sin(ang).astype(dtype)


def _rotate(xh, cos, sin):
    half = xh.shape[-1] // 2
    x1, x2 = xh[..., :half], xh[..., half:]
    return jnp.concatenate([x1 * cos - x2 * sin, x2 * cos + x1 * sin], axis=-1)


def apply_axial_rope(x, cos_t, sin_t):
    nf = ROPE_AXIS_DIM // 2
    cr, sr = cos_t[:, None, :nf], sin_t[:, None, :nf]
    cc, sc = cos_t[:, None, nf:], sin_t[:, None, nf:]
    return jnp.concatenate([_rotate(x[..., :ROPE_AXIS_DIM], cr, sr), _rotate(x[..., ROPE_AXIS_DIM:], cc, sc)], axis=-1)


def neighborhood_attention(q, k, v, k_ctx, v_ctx, rpb):
    bsz, n, nh, hd = q.shape
    rows = n // GRID_W
    kh = min(NA_KH, rows)
    scale = hd ** -0.5
    qg = q.reshape(bsz, rows, GRID_W, nh, hd).transpose(1, 0, 2, 3, 4)
    kg = k.reshape(bsz, rows, GRID_W, nh, hd)
    vg = v.reshape(bsz, rows, GRID_W, nh, hd)
    cq = jnp.arange(GRID_W)
    col_start = jnp.clip(cq - NA_KW // 2, 0, GRID_W - NA_KW)
    col_idx = col_start[:, None] + jnp.arange(NA_KW)[None, :]
    dcol = col_idx - cq[:, None] + (NA_KW - 1)
    rpb_col = rpb[:, :, dcol]
    n_win = kh * NA_KW

    def one_row(args):
        r, q_r = args
        rs = jnp.clip(r - kh // 2, 0, rows - kh)
        k_blk = lax.dynamic_slice_in_dim(kg, rs, kh, axis=1)
        v_blk = lax.dynamic_slice_in_dim(vg, rs, kh, axis=1)
        k_win = k_blk[:, :, col_idx]
        v_win = v_blk[:, :, col_idx]
        drow = rs + jnp.arange(kh) - r + (NA_KH - 1)
        bias = rpb_col[:, drow].transpose(0, 2, 1, 3)
        s_win = jnp.einsum('bqhd,brqwhd->bhqrw', q_r, k_win).astype(jnp.float32) * scale + bias.astype(jnp.float32)
        s_ctx = jnp.einsum('bqhd,bchd->bhqc', q_r, k_ctx).astype(jnp.float32) * scale
        s = jnp.concatenate([s_win.reshape(bsz, nh, GRID_W, n_win), s_ctx], axis=-1)
        p = jax.nn.softmax(s, axis=-1).astype(v.dtype)
        p_win = p[..., :n_win].reshape(bsz, nh, GRID_W, kh, NA_KW)
        p_ctx = p[..., n_win:]
        return (jnp.einsum('bhqrw,brqwhd->bqhd', p_win, v_win)
                + jnp.einsum('bhqc,bchd->bqhd', p_ctx, v_ctx))

    out = lax.map(one_row, (jnp.arange(rows), qg))
    return out.transpose(1, 0, 2, 3, 4).reshape(bsz, n, nh * hd)


def context_attention(q, k, v):
    bsz, l = q.shape[0], q.shape[1]
    s = jnp.einsum('blhd,bmhd->bhlm', q, k).astype(jnp.float32) * (HEAD_DIM ** -0.5)
    p = jax.nn.softmax(s, axis=-1).astype(v.dtype)
    return jnp.einsum('bhlm,bmhd->blhd', p, v).reshape(bsz, l, NA_WIDTH)


def pool_mix(u, w_pool, pool_scale):
    bsz, n, _ = u.shape
    uf = u.astype(jnp.float32).reshape(bsz, n, POOL_GROUPS, POOL_GROUP_DIM)
    cs = jnp.concatenate([jnp.zeros_like(uf[:, :1]), jnp.cumsum(uf, axis=1)], axis=1)
    t = jnp.arange(n)
    outs = []
    for gi, w in enumerate(POOL_WINDOWS):
        lo = w // 2
        hi = w - lo - 1
        start = jnp.clip(t - lo, 0, n)
        end = jnp.clip(t + hi + 1, 0, n)
        csg = cs[:, :, gi]
        cnt = (end - start).astype(jnp.float32)[None, :, None]
        outs.append((csg[:, end] - csg[:, start]) / cnt - uf[:, :, gi])
    d = jnp.stack(outs, axis=2)
    y = jnp.einsum('bngc,gcd->bngd', d, w_pool.astype(jnp.float32)).reshape(bsz, n, POOL_WIDTH)
    return (y * pool_scale.astype(jnp.float32)).astype(u.dtype)


def fourier_mix(u):
    bsz, n, _ = u.shape
    uf = u.astype(jnp.float32).reshape(bsz, n, FOURIER_GROUPS, FOURIER_GROUP_DIM)
    y = jnp.fft.fft2(uf, axes=(1, 3), norm='ortho').real
    return y.reshape(bsz, n, FOURIER_WIDTH).astype(u.dtype)


def conv_module(u2, w_dw, b_dw, ln_g, ln_b):
    a, g = u2[..., :CONV_WIDTH], u2[..., CONV_WIDTH:]
    z = a * jax.nn.sigmoid(g)
    z = lax.conv_general_dilated(z, w_dw.reshape(CONV_K, 1, CONV_WIDTH).astype(z.dtype), window_strides=(1,),
                                 padding=[(CONV_K // 2, CONV_K // 2)], dimension_numbers=('NWC', 'WIO', 'NWC'),
                                 feature_group_count=CONV_WIDTH) + b_dw
    zf = z.astype(jnp.float32)
    mu = jnp.mean(zf, axis=-1, keepdims=True)
    var = jnp.mean(jnp.square(zf - mu), axis=-1, keepdims=True)
    zf = (zf - mu) * lax.rsqrt(var + EPS) * ln_g.astype(jnp.float32) + ln_b.astype(jnp.float32)
    return jax.nn.silu(zf).astype(u2.dtype)


def mixer_output(attn, p, w_pool, pool_scale, w_dw, b_dw, ln_g, ln_b,
                 w_br_attn, w_br_pool, w_br_fourier, w_br_conv, w_out):
    y_attn = attn @ w_br_attn
    y_pool = pool_mix(p[..., POOL_OFF:FOUR_OFF], w_pool, pool_scale) @ w_br_pool
    y_four = fourier_mix(p[..., FOUR_OFF:CONV_OFF]) @ w_br_fourier
    y_conv = conv_module(p[..., CONV_OFF:GATE_OFF], w_dw, b_dw, ln_g, ln_b) @ w_br_conv
    g = jax.nn.sigmoid(p[..., GATE_OFF:])
    merged = (g[..., :D_MODEL] * y_attn + g[..., D_MODEL:2 * D_MODEL] * y_pool
              + g[..., 2 * D_MODEL:3 * D_MODEL] * y_four + g[..., 3 * D_MODEL:] * y_conv)
    return merged @ w_out


def sq_relu_mlp(h, w1, w2):
    return jnp.square(jax.nn.relu(h @ w1)) @ w2


def setup_inputs(seed: int = 0) -> dict:
    key = jax.random.key(seed)
    ks = jax.random.split(key, 24)
    f32 = jnp.float32
    L, D = DEPTH, D_MODEL

    def nrm(k, shape, s):
        return jax.random.normal(k, shape, f32) * s

    return {
        "x": nrm(ks[0], (BATCH, SEQ, D), 1.0),
        "c": nrm(ks[1], (BATCH, D), 1.0),
        "ctx": nrm(ks[2], (BATCH, CTX_LEN, D), 1.0),
        "c_ctx": nrm(ks[3], (D,), 1.0),
        "w_mod": nrm(ks[4], (L, D, 6 * D), 0.5 * D ** -0.5),
        "b_mod": nrm(ks[5], (L, 6 * D), 0.02),
        "g_mix": 1.0 + nrm(ks[6], (L, D), 0.02),
        "g_ff": 1.0 + nrm(ks[7], (L, D), 0.02),
        "w_in": nrm(ks[8], (L, D, IN_WIDTH), D ** -0.5),
        "rpb": nrm(ks[9], (L, NA_HEADS, 2 * NA_KH - 1, 2 * NA_KW - 1), 0.1),
        "w_pool": nrm(ks[10], (L, POOL_GROUPS, POOL_GROUP_DIM, POOL_GROUP_DIM), POOL_GROUP_DIM ** -0.5),
        "pool_scale": 1.0 + nrm(ks[11], (L, POOL_WIDTH), 0.02),
        "w_dw": nrm(ks[12], (L, CONV_K, CONV_WIDTH), CONV_K ** -0.5),
        "b_dw": nrm(ks[13], (L, CONV_WIDTH), 0.02),
        "conv_ln_g": 1.0 + nrm(ks[14], (L, CONV_WIDTH), 0.02),
        "conv_ln_b": nrm(ks[15], (L, CONV_WIDTH), 0.02),
        "w_br_attn": nrm(ks[16], (L, NA_WIDTH, D), NA_WIDTH ** -0.5),
        "w_br_pool": nrm(ks[17], (L, POOL_WIDTH, D), POOL_WIDTH ** -0.5),
        "w_br_fourier": nrm(ks[18], (L, FOURIER_WIDTH, D), FOURIER_WIDTH ** -0.5),
        "w_br_conv": nrm(ks[19], (L, CONV_WIDTH, D), CONV_WIDTH ** -0.5),
        "w_out": nrm(ks[20], (L, D, D), D ** -0.5),
        "w_ff1": nrm(ks[21], (L, D, D_FF), D ** -0.5),
        "w_ff2": nrm(ks[22], (L, D_FF, D), D_FF ** -0.5),
        "g_final": 1.0 + nrm(ks[23], (D,), 0.02),
    }


def reference(x, c, ctx, c_ctx, w_mod, b_mod, g_mix, g_ff, w_in, rpb, w_pool, pool_scale, w_dw, b_dw,
              conv_ln_g, conv_ln_b, w_br_attn, w_br_pool, w_br_fourier, w_br_conv, w_out, w_ff1, w_ff2, g_final):
    n = x.shape[1]
    cos_t, sin_t = axial_rope_tables(n, x.dtype)
    h_ctx = ctx
    for l in range(DEPTH):
        last = l == DEPTH - 1
        tails = (w_pool[l], pool_scale[l], w_dw[l], b_dw[l], conv_ln_g[l], conv_ln_b[l],
                 w_br_attn[l], w_br_pool[l], w_br_fourier[l], w_br_conv[l], w_out[l])
        if last:
            sh1c, sc1c = ada(c_ctx, w_mod[l], b_mod[l], 2)
            hc = modulate(rmsnorm(h_ctx, g_mix[l]), sh1c, sc1c)
            kv = hc @ w_in[l][:, K_OFF:POOL_OFF]
            hs = kv.shape[:-1] + (NA_HEADS, HEAD_DIM)
            k_c = kv[..., :NA_WIDTH].reshape(hs)
            v_c = kv[..., NA_WIDTH:].reshape(hs)
        else:
            sh1c, sc1c, gt1c, sh2c, sc2c, gt2c = ada(c_ctx, w_mod[l], b_mod[l], 6)
            hc = modulate(rmsnorm(h_ctx, g_mix[l]), sh1c, sc1c)
            pc = hc @ w_in[l]
            q_c, k_c, v_c = split_qkv(pc)
            ctx_next = h_ctx + gt1c * mixer_output(context_attention(q_c, k_c, v_c), pc, *tails)
            hc2 = modulate(rmsnorm(ctx_next, g_ff[l]), sh2c, sc2c)
            ctx_next = ctx_next + gt2c * sq_relu_mlp(hc2, w_ff1[l], w_ff2[l])
        sh1, sc1, gt1, sh2, sc2, gt2 = ada(c, w_mod[l], b_mod[l], 6)
        h = modulate(rmsnorm(x, g_mix[l]), sh1, sc1)
        p = h @ w_in[l]
        q, k, v = split_qkv(p)
        q = apply_axial_rope(q, cos_t, sin_t)
        k = apply_axial_rope(k, cos_t, sin_t)
        attn = neighborhood_attention(q, k, v, k_c, v_c, rpb[l])
        x = x + gt1 * mixer_output(attn, p, *tails)
        h2 = modulate(rmsnorm(x, g_ff[l]), sh2, sc2)
        x = x + gt2 * sq_relu_mlp(h2, w_ff1[l], w_ff2[l])
        if not last:
            h_ctx = ctx_next
    return rmsnorm(x, g_final)
```

```cpp
#include <hip/hip_runtime.h>
#include <hip/hip_cooperative_groups.h>
#include <cstdio>
#include <cstdint>
namespace cg = cooperative_groups;

#define LAS __attribute__((address_space(3)))
typedef unsigned short bf16_t;
typedef short bf16x8 __attribute__((ext_vector_type(8)));
typedef short s16x4 __attribute__((ext_vector_type(4)));
typedef float f32x4 __attribute__((ext_vector_type(4)));
typedef float f32x2 __attribute__((ext_vector_type(2)));
typedef unsigned u32x4 __attribute__((ext_vector_type(4)));
typedef unsigned u32x2 __attribute__((ext_vector_type(2)));

#ifndef PHMASK
#define PHMASK 0xFFFF
#endif
#define PHON(j) (((PHMASK) >> (j)) & 1)
#ifndef REP2
#define REP2 0
#endif
#ifndef REPMASK
#define REPMASK 0
#endif
#define NREP(j) (1 + (((REPMASK) >> (j)) & 1))
#ifndef EXPM2
#define EXPM2 0
#endif
#ifndef EXPM
#define EXPM 0
#endif
#ifndef MK_ONE_LAUNCH
#define MK_ONE_LAUNCH 1
#endif

constexpr int D = 1024, NBATCH = 4, SEQ = 8192, NL = 4, CTXL = 256, DFF = 4096;
constexpr int ML = NBATCH * SEQ;
constexpr int MC = NBATCH * CTXL;
constexpr int M = ML + MC;
constexpr int INW = 6656;
constexpr int W_Q = 0, W_K = 512, W_V = 1024, W_POOL = 1536, W_FOUR = 1792, W_CONV = 2048, W_GATE = 2560;
constexpr int LDP = 1792;
constexpr int PQ = 0, PK = 512, PPOOL = 1024, PCA = 1280, PCG = 1536;
constexpr int NWAVES = 8, NT = 512;
constexpr int LDS_BYTES = 147456;

constexpr size_t MiB = 1u << 20;
constexpr size_t WS_MOD = 0;
constexpr size_t WS_ROPE = 1 * MiB;
constexpr size_t WS_TW = 1 * MiB + 65536;
constexpr size_t WS_DFT = 2 * MiB;
constexpr size_t DFT_C128 = 0, DFT_S128 = 32768, DFT_C64 = 65536, DFT_S64 = 65536 + 8192, DFT_C256 = 65536 + 16384, DFT_S256 = 65536 + 16384 + 131072;
constexpr size_t WS_XC = 3 * MiB;
constexpr size_t WS_WT = 7 * MiB;
constexpr size_t WT_NAT = 0, WT_V = WT_NAT + 1792 * 1024, WT_F = WT_V + 512 * 1024, WT_G = WT_F + 512 * 1024, WT_BA = WT_G + 4096 * 1024,
                 WT_BP = WT_BA + 1024 * 512, WT_BF = WT_BP + 1024 * 256, WT_BC = WT_BF + 1024 * 256, WT_O = WT_BC + 1024 * 256,
                 WT_1 = WT_O + 1024 * 1024, WT_2 = WT_1 + 4096 * 1024, WT_END = WT_2 + 4096 * 1024;
static_assert(WT_END * 2 == 34 * MiB, "weight map");
constexpr size_t WS_XB = 41 * MiB;
constexpr size_t WS_R1 = 107 * MiB;
constexpr size_t R1_MG = 0, R1_GYC = 66 * MiB, R1_YSCR = 80 * MiB, R1_GC = 216 * MiB;
constexpr size_t R1_P = 0, R1_VT = 116 * MiB, R1_ZA = 149 * MiB, R1_ZC = 181 * MiB, R1_TP = 182 * MiB;
constexpr size_t WS_R2 = 371 * MiB;
constexpr size_t R2_ATTN = 0, R2_POOL = 33 * MiB, R2_FOUR = R2_POOL + (size_t)M * 256 * 2, R2_CONV = R2_FOUR + (size_t)M * 256 * 2;
constexpr size_t OUT_PB6 = 66 * MiB;
constexpr size_t WS_END = 455 * MiB;
static_assert(R2_CONV + (size_t)M * 256 * 2 <= 84 * MiB && (size_t)M * LDP * 2 <= 116 * MiB, "ws map");

typedef __bf16 bf16x2_t __attribute__((ext_vector_type(2)));
__device__ __forceinline__ unsigned cvt_pk_bf16(float lo, float hi) { const f32x2 v = {lo, hi}; const bf16x2_t b = __builtin_convertvector(v, bf16x2_t); return __builtin_bit_cast(unsigned, b); }
__device__ __forceinline__ bf16_t f2bf(float f) { unsigned u = __builtin_bit_cast(unsigned, f); return (bf16_t)((u + 0x7fffu + ((u >> 16) & 1u)) >> 16); }
__device__ __forceinline__ float bf2f(bf16_t b) { return __builtin_bit_cast(float, (unsigned)b << 16); }
__device__ __forceinline__ float bflo(unsigned w) { return __builtin_bit_cast(float, w << 16); }
__device__ __forceinline__ float bfhi(unsigned w) { return __builtin_bit_cast(float, w & 0xffff0000u); }
__device__ __forceinline__ float wave_sum(float v) {
#pragma unroll
    for (int o = 1; o < 64; o <<= 1) v += __shfl_xor(v, o);
    return v;
}
__device__ __forceinline__ float sigmoidf_(float x) { return __builtin_amdgcn_rcpf(1.0f + __builtin_amdgcn_exp2f(-1.4426950408889634f * x)); }
#define MFMA16(a, b, c) __builtin_amdgcn_mfma_f32_16x16x32_bf16((a), (b), (c), 0, 0, 0)

namespace pg8 {
constexpr int BM = 256, BK = 64, HALF = 128, HTB = HALF * BK * 2, STAGE_BYTES = 8 * HTB, NXCD = 8, WGM = 8;
__host__ __device__ __forceinline__ int lds_byte(int r, int c) { const int st = (r >> 4) * 2 + (c >> 5), rr = r & 15, cc = c & 31, ob = rr * 64 + cc * 2; return st * 1024 + (ob ^ (((ob >> 9) & 1) << 5)); }
__host__ __device__ __forceinline__ void stage_rc(int b, int& R, int& C) { const int st = b / 1024, sb = b % 1024, swz = sb ^ (((sb >> 9) & 1) << 5); R = (st >> 1) * 16 + swz / 64; C = (st & 1) * 32 + (swz % 64) / 2; }
__host__ __device__ __forceinline__ int perm32(int rho) { const int n = rho >> 4, i = rho & 15; return 8 * (i >> 2) + 4 * n + (i & 3); }

struct Unit { const char* a; const char* b; int pm, pn, kind, lda, ldb, nt; };

__device__ __forceinline__ void tile_map(int L, int nM, int nN, int& pm, int& pn) {
    const int nwg = nM * nN; int wgid = L;
    { const int q = nwg / NXCD, r = nwg % NXCD, xcd = wgid % NXCD, off = wgid / NXCD; wgid = (xcd < r ? xcd * (q + 1) : r * (q + 1) + (xcd - r) * q) + off; }
    const int nig = WGM * nN, gid = wgid / nig, fm = gid * WGM, gsz = (nM - fm) < WGM ? (nM - fm) : WGM;
    pm = fm + ((wgid % nig) % gsz); pn = (wgid % nig) / gsz;
}

template <class Epi, class Sched>
__device__ __forceinline__ void gemm_phase(LAS unsigned char* lds, const int tid, const Sched& S, const Epi& E) {
    const int wid = __builtin_amdgcn_readfirstlane(tid >> 6), lane = tid & 63, wr = wid >> 2, wc = wid & 3, fr = lane & 15, fq = lane >> 4;
    int R0, C0; stage_rc(tid * 16, R0, C0); const int Rb0 = Epi::PERM ? ((R0 & ~31) + perm32(R0 & 31)) : R0;
    const size_t kstep = (size_t)(BK * 2);
    const unsigned ldsw = (unsigned)wid * 1024u;
    const int aoff = lds_byte(wr * 64 + fr, fq * 8), boff = lds_byte(wc * 32 + fr, fq * 8);
#define PG8_SA(b, h) (((b) * 2 + (h)) * HTB)
#define PG8_SB(b, h) ((4 + (b) * 2 + (h)) * HTB)
#define PG8_STAGE(bufoff, gbase, voff, hstep) do { _Pragma("unroll") for (int _i = 0; _i < 2; ++_i) \
        __builtin_amdgcn_global_load_lds((const unsigned*)((const char*)(gbase) + (size_t)_i * ((hstep) >> 1) + (voff)), (LAS unsigned*)(lds + (bufoff) + ldsw + _i * 8192), 16, 0, 0); } while (0)
#define PG8_LDA(dst, b, h) do { _Pragma("unroll") for (int m = 0; m < 4; ++m) _Pragma("unroll") for (int k = 0; k < 2; ++k) dst[m][k] = *(const LAS bf16x8*)(lds + PG8_SA(b, h) + aoff + m * 2048 + k * 1024); } while (0)
#define PG8_LDB(dst, b, h) do { _Pragma("unroll") for (int n = 0; n < 2; ++n) _Pragma("unroll") for (int k = 0; k < 2; ++k) dst[n][k] = *(const LAS bf16x8*)(lds + PG8_SB(b, h) + boff + n * 2048 + k * 1024); } while (0)
#define PG8_MMA(ai, bj, At, Bt) do { __builtin_amdgcn_s_setprio(1); _Pragma("unroll") for (int m = 0; m < 4; ++m) _Pragma("unroll") for (int n = 0; n < 2; ++n) _Pragma("unroll") for (int k = 0; k < 2; ++k) \
        acc[ai][bj][m][n] = __builtin_amdgcn_mfma_f32_16x16x32_bf16(Bt[n][k], At[m][k], acc[ai][bj][m][n], 0, 0, 0); __builtin_amdgcn_s_setprio(0); } while (0)
#define PG8_WAIT_V(n) asm volatile("s_waitcnt vmcnt(" #n ")" ::: "memory")
#define PG8_WAIT_L(n) asm volatile("s_waitcnt lgkmcnt(" #n ")" ::: "memory")
#define PG8_BAR __builtin_amdgcn_s_barrier()
#define PG8_SCHED __builtin_amdgcn_sched_barrier(0)
    Unit cur, nxt; int ui = 0;
    if (!S.next(0, cur)) return;
    f32x4 acc[2][2][4][2];
#pragma unroll
    for (int a = 0; a < 2; ++a)
#pragma unroll
        for (int b = 0; b < 2; ++b)
#pragma unroll
            for (int m = 0; m < 4; ++m)
#pragma unroll
                for (int n = 0; n < 2; ++n) acc[a][b][m][n] = (f32x4){0.f, 0.f, 0.f, 0.f};
    bf16x8 At[4][2], B0[2][2], B1[2][2];
    const char* cA = cur.a; const char* cB = cur.b;
    unsigned vAc = (unsigned)(R0 * cur.lda + C0) * 2u, vBc = (unsigned)(Rb0 * cur.ldb + C0) * 2u;
    size_t hAc = (size_t)HALF * cur.lda * 2, hBc = (size_t)HALF * cur.ldb * 2;
    PG8_STAGE(PG8_SB(0, 0), cB, vBc, hBc); PG8_STAGE(PG8_SA(0, 0), cA, vAc, hAc); PG8_STAGE(PG8_SB(0, 1), cB + hBc, vBc, hBc); PG8_STAGE(PG8_SA(0, 1), cA + hAc, vAc, hAc);
    if (wr == 1) PG8_BAR;
    PG8_WAIT_V(4); PG8_BAR;
    PG8_STAGE(PG8_SB(1, 0), cB + kstep, vBc, hBc); PG8_STAGE(PG8_SA(1, 0), cA + kstep, vAc, hAc); PG8_STAGE(PG8_SB(1, 1), cB + hBc + kstep, vBc, hBc);
    PG8_WAIT_V(6); PG8_BAR;
    for (;;) {
        const bool has_next = S.next(ui + 1, nxt);
        const char* nA = has_next ? nxt.a : cA; const char* nB = has_next ? nxt.b : cB;
        const unsigned vAn = has_next ? (unsigned)(R0 * nxt.lda + C0) * 2u : vAc, vBn = has_next ? (unsigned)(Rb0 * nxt.ldb + C0) * 2u : vBc;
        const size_t hAn = has_next ? (size_t)HALF * nxt.lda * 2 : hAc, hBn = has_next ? (size_t)HALF * nxt.ldb * 2 : hBc;
        const int nt = cur.nt;
        for (int t = 0; t < nt; t += 2) {
            const bool last = (t == nt - 2);
            const char* a1 = cA + (size_t)(t + 1) * kstep;
            const char* a2 = last ? nA : cA + (size_t)(t + 2) * kstep; const char* b2 = last ? nB : cB + (size_t)(t + 2) * kstep;
            const char* a3 = a2 + kstep; const char* b3 = b2 + kstep;
            const unsigned vA2 = last ? vAn : vAc, vB2 = last ? vBn : vBc;
            const size_t hA2 = last ? hAn : hAc, hB2 = last ? hBn : hBc;
            PG8_LDB(B0, 0, 0); PG8_SCHED; PG8_LDA(At, 0, 0); PG8_STAGE(PG8_SA(1, 1), a1 + hAc, vAc, hAc);
            PG8_WAIT_L(8); PG8_BAR; PG8_WAIT_L(0); PG8_MMA(0, 0, At, B0); PG8_BAR; PG8_SCHED;
            PG8_LDB(B1, 0, 1); PG8_STAGE(PG8_SB(0, 0), b2, vB2, hB2);
            PG8_BAR; PG8_WAIT_L(0); PG8_MMA(0, 1, At, B1); PG8_BAR;
            PG8_LDA(At, 0, 1); PG8_STAGE(PG8_SA(0, 0), a2, vA2, hA2);
            PG8_BAR; PG8_WAIT_L(0); PG8_MMA(1, 0, At, B0); PG8_BAR; PG8_SCHED;
            PG8_STAGE(PG8_SB(0, 1), b2 + hB2, vB2, hB2);
            PG8_WAIT_V(6); PG8_BAR; PG8_MMA(1, 1, At, B1); PG8_BAR;
            PG8_LDB(B0, 1, 0); PG8_SCHED; PG8_LDA(At, 1, 0); PG8_STAGE(PG8_SA(0, 1), a2 + hA2, vA2, hA2);
            PG8_WAIT_L(8); PG8_BAR; PG8_WAIT_L(0); PG8_MMA(0, 0, At, B0); PG8_BAR; PG8_SCHED;
            PG8_LDB(B1, 1, 1); PG8_STAGE(PG8_SB(1, 0), b3, vB2, hB2);
            PG8_BAR; PG8_WAIT_L(0); PG8_MMA(0, 1, At, B1); PG8_BAR;
            PG8_LDA(At, 1, 1); PG8_STAGE(PG8_SA(1, 0), a3, vA2, hA2);
            PG8_BAR; PG8_WAIT_L(0); PG8_MMA(1, 0, At, B0); PG8_BAR; PG8_SCHED;
            PG8_STAGE(PG8_SB(1, 1), b3 + hB2, vB2, hB2);
            PG8_WAIT_V(6); PG8_BAR; PG8_MMA(1, 1, At, B1); PG8_BAR;
        }
        E(acc, cur, wr, wc, fr, fq);
        if (!has_next) break;
#pragma unroll
        for (int a = 0; a < 2; ++a)
#pragma unroll
            for (int b = 0; b < 2; ++b)
#pragma unroll
                for (int m = 0; m < 4; ++m)
#pragma unroll
                    for (int n = 0; n < 2; ++n) acc[a][b][m][n] = (f32x4){0.f, 0.f, 0.f, 0.f};
        cur = nxt; cA = nA; cB = nB; vAc = vAn; vBc = vBn; hAc = hAn; hBc = hBn; ++ui;
    }
    PG8_WAIT_V(0);
    if (wr == 0) PG8_BAR;
    PG8_BAR;
#undef PG8_SA
#undef PG8_SB
#undef PG8_STAGE
#undef PG8_LDA
#undef PG8_LDB
#undef PG8_MMA
#undef PG8_WAIT_V
#undef PG8_WAIT_L
#undef PG8_BAR
#undef PG8_SCHED
}
}
using pg8::Unit;

struct Args {
    const float* in[24];
    float* out; unsigned char* ws;
    int ph_lo, ph_hi;
};
enum { I_X = 0, I_C, I_CTX, I_CCTX, I_WMOD, I_BMOD, I_GMIX, I_GFF, I_WIN, I_RPB, I_WPOOL, I_PSCALE, I_WDW, I_BDW, I_LNG, I_LNB, I_WBA, I_WBP, I_WBF, I_WBC, I_WOUT, I_WFF1, I_WFF2, I_GFINAL };

#define KAS __attribute__((address_space(4)))
typedef const float* cfp;
struct Frame {
    LAS unsigned char* lds;
    int tid, lane, wave, G, bid;
    const KAS cfp* in;
    float* out; unsigned char* ws;
    float* MOD; const f32x2* ROPE; const f32x2* TW; const bf16_t* DFT; float* XC;
    bf16_t* WT; bf16_t* H; bf16_t* XB; bf16_t* P; bf16_t* VT; bf16_t* ZA; bf16_t* ZC; bf16_t* TP; bf16_t* Y; bf16_t* U;
    bf16_t* ATTN; bf16_t* POOLO; bf16_t* FOURO; bf16_t* CONVO; bf16_t* MERGED;
};
__device__ __forceinline__ const float* mod_ptr(const Frame& F, int l, int mi, int chunk) { return F.MOD + ((size_t)(l * 5 + mi) * 6 + chunk) * D; }
__device__ __forceinline__ int row_mi(int row) { return row < ML ? (row >> 13) : 4; }
__device__ __forceinline__ int tile_mi(int pm) { return pm < 128 ? (pm >> 5) : 4; }

__device__ __forceinline__ void p0_prologue(Frame& F) {
    LAS float* sv = (LAS float*)F.lds;
    LAS float* red = (LAS float*)(F.lds + 5 * 1024 * 4);
    const float* c = F.in[I_C]; const float* cc = F.in[I_CCTX];
    for (int i = F.tid; i < 5 * D; i += NT) { const float v = (i < 4 * D) ? c[i] : cc[i - 4 * D]; sv[i] = v / (1.0f + __expf(-v)); }
    __syncthreads();
    for (int it = F.bid; it < NL * 48; it += F.G) {
        const int l = it / 48, n0 = (it % 48) * 128;
        const float* w = F.in[I_WMOD] + (size_t)l * D * 6144 + n0 + 2 * F.lane;
        float a[5][2];
#pragma unroll
        for (int j = 0; j < 5; ++j) { a[j][0] = 0.f; a[j][1] = 0.f; }
        const int k0 = F.wave * 128;
#pragma unroll 4
        for (int k = k0; k < k0 + 128; ++k) {
            const f32x2 wv = *(const f32x2*)(w + (size_t)k * 6144);
#pragma unroll
            for (int j = 0; j < 5; ++j) { const float s = sv[j * D + k]; a[j][0] += s * wv.x; a[j][1] += s * wv.y; }
        }
#pragma unroll
        for (int j = 0; j < 5; ++j) { red[(F.wave * 5 + j) * 128 + 2 * F.lane] = a[j][0]; red[(F.wave * 5 + j) * 128 + 2 * F.lane + 1] = a[j][1]; }
        __syncthreads();
        for (int o = F.tid; o < 5 * 128; o += NT) {
            const int j = o >> 7, n = o & 127; float s = 0.f;
#pragma unroll
            for (int wv = 0; wv < 8; ++wv) s += red[(wv * 5 + j) * 128 + n];
            F.MOD[(size_t)(l * 5 + j) * 6144 + n0 + n] = s + F.in[I_BMOD][l * 6144 + n0 + n];
        }
        __syncthreads();
    }
    const int gt = F.bid * NT + F.tid, GT = F.G * NT;
    f32x2* rope = (f32x2*)(F.ws + WS_ROPE);
    for (int i = gt; i < 128 * 16; i += GT) { const int pos = i >> 4, f = i & 15; const float inv = powf(10000.0f, -(float)(2 * f) / 32.0f); const float ang = (float)pos * inv; rope[i] = (f32x2){cosf(ang), sinf(ang)}; }
    f32x2* tw = (f32x2*)(F.ws + WS_TW);
    for (int i = gt; i < 8192; i += GT) { const float ang = 6.283185307179586f * (float)i / 8192.0f; tw[i] = (f32x2){cosf(ang), sinf(ang)}; }
    bf16_t* dft = (bf16_t*)(F.ws + WS_DFT);
    for (int i = gt; i < 128 * 128; i += GT) { const int k = i >> 7, n = i & 127; const float ang = 6.283185307179586f * (float)((k * n) & 127) / 128.0f; dft[DFT_C128 / 2 + i] = f2bf(cosf(ang)); dft[DFT_S128 / 2 + i] = f2bf(sinf(ang)); }
    for (int i = gt; i < 64 * 64; i += GT) { const int k = i >> 6, n = i & 63; const float ang = 6.283185307179586f * (float)((k * n) & 63) / 64.0f; dft[DFT_C64 / 2 + i] = f2bf(cosf(ang)); dft[DFT_S64 / 2 + i] = f2bf(sinf(ang)); }
    for (int i = gt; i < 256 * 256; i += GT) { const int k = i >> 8, n = i & 255; const float ang = 6.283185307179586f * (float)((k * n) & 255) / 256.0f; dft[DFT_C256 / 2 + i] = f2bf(cosf(ang)); dft[DFT_S256 / 2 + i] = f2bf(sinf(ang)); }
}

__device__ __forceinline__ void tr_item(const float* W, int ldw, int col0, int nblk, bf16_t* WT, int K, int drow0, LAS float* scr, int item, int lane) {
    const int kb = item / nblk, nb = item % nblk, k0 = 64 * kb, n0 = 32 * nb;
#pragma unroll 8
    for (int i = 0; i < 32; ++i) { const int kk = 2 * i + (lane >> 5); scr[kk * 33 + (lane & 31)] = W[(size_t)(k0 + kk) * ldw + col0 + n0 + (lane & 31)]; }
    asm volatile("s_waitcnt lgkmcnt(0)" ::: "memory");
    const int c = lane & 7;
#pragma unroll
    for (int j = 0; j < 4; ++j) { const int n = (lane >> 3) + 8 * j; const LAS float* s = scr + (8 * c) * 33 + n;
        u32x4 o; o.x = cvt_pk_bf16(s[0 * 33], s[1 * 33]); o.y = cvt_pk_bf16(s[2 * 33], s[3 * 33]); o.z = cvt_pk_bf16(s[4 * 33], s[5 * 33]); o.w = cvt_pk_bf16(s[6 * 33], s[7 * 33]);
        *(u32x4*)(WT + (size_t)(drow0 + n0 + n) * K + k0 + 8 * c) = o; }
    asm volatile("s_waitcnt lgkmcnt(0)" ::: "memory");
}
__device__ __forceinline__ void convert_weights(Frame& F, int l) {
    LAS float* scr = (LAS float*)(F.lds + F.wave * 8448);
    const int gw = F.bid * NWAVES + F.wave, NGW = F.G * NWAVES;
    const float* win = F.in[I_WIN] + (size_t)l * D * INW;
    bf16_t* WT = F.WT;
    for (int it = gw; it < 8448; it += NGW) {
        int r = it;
        if (r < 256) { tr_item(win, INW, W_Q, 16, WT + WT_NAT, 1024, 0, scr, r, F.lane); continue; } r -= 256;
        if (r < 256) { tr_item(win, INW, W_K, 16, WT + WT_NAT, 1024, 512, scr, r, F.lane); continue; } r -= 256;
        if (r < 128) { tr_item(win, INW, W_POOL, 8, WT + WT_NAT, 1024, 1024, scr, r, F.lane); continue; } r -= 128;
        if (r < 256) { tr_item(win, INW, W_CONV, 16, WT + WT_NAT, 1024, 1280, scr, r, F.lane); continue; } r -= 256;
        if (r < 256) { tr_item(win, INW, W_V, 16, WT + WT_V, 1024, 0, scr, r, F.lane); continue; } r -= 256;
        if (r < 2048) { tr_item(win, INW, W_GATE, 128, WT + WT_G, 1024, 0, scr, r, F.lane); continue; } r -= 2048;
        if (r < 256) { tr_item(F.in[I_WBA] + (size_t)l * 512 * D, D, 0, 32, WT + WT_BA, 512, 0, scr, r, F.lane); continue; } r -= 256;
        if (r < 128) { tr_item(F.in[I_WBP] + (size_t)l * 256 * D, D, 0, 32, WT + WT_BP, 256, 0, scr, r, F.lane); continue; } r -= 128;
        if (r < 128) { tr_item(F.in[I_WBF] + (size_t)l * 256 * D, D, 0, 32, WT + WT_BF, 256, 0, scr, r, F.lane); continue; } r -= 128;
        if (r < 128) { tr_item(F.in[I_WBC] + (size_t)l * 256 * D, D, 0, 32, WT + WT_BC, 256, 0, scr, r, F.lane); continue; } r -= 128;
        if (r < 512) { tr_item(F.in[I_WOUT] + (size_t)l * D * D, D, 0, 32, WT + WT_O, 1024, 0, scr, r, F.lane); continue; } r -= 512;
        if (r < 2048) { tr_item(F.in[I_WFF1] + (size_t)l * D * DFF, DFF, 0, 128, WT + WT_1, 1024, 0, scr, r, F.lane); continue; } r -= 2048;
        tr_item(F.in[I_WFF2] + (size_t)l * DFF * D, D, 0, 32, WT + WT_2, 4096, 0, scr, r, F.lane);
    }
    __syncthreads();
    LAS float* st = (LAS float*)F.lds;
    LAS float* ct = (LAS float*)(F.lds + 64 * 65 * 4);
    for (int it = F.bid; it < 256; it += F.G) {
        const int g = it >> 6, k0 = ((it >> 2) & 15) * 64, jq = it & 3;
        for (int i = F.tid; i < 64 * 64; i += NT) { const int kk = i >> 6, cch = i & 63; st[kk * 65 + cch] = win[(size_t)(k0 + kk) * INW + W_FOUR + 64 * g + cch]; }
        if (F.tid < 64) { const float ang = 6.283185307179586f * (float)F.tid / 64.0f; ct[F.tid] = cosf(ang); ct[64 + F.tid] = sinf(ang); }
        __syncthreads();
        const int kk = F.tid & 63, jg = F.tid >> 6;
        for (int jj = 0; jj < 4; ++jj) {
            const int jp = 32 * jq + 4 * jg + jj, ri = jp >> 6, cp = jp & 63; float a = 0.f;
            for (int cch = 0; cch < 64; ++cch) a += st[kk * 65 + cch] * ct[ri * 64 + ((cch * cp) & 63)];
            a *= ri ? -0.125f : 0.125f;
            WT[WT_F + (size_t)(ri * 256 + g * 64 + cp) * 1024 + k0 + kk] = f2bf(a);
        }
        __syncthreads();
    }
}

__device__ __forceinline__ void norm_mod_rows(Frame& F, int l, const float* xl  , const float* xc, float* xcw, const float* pb, int nsplit, const float* pgate,
                                              const float* g, int ch_shift, int ch_scale, int nrows) {
    const int gw = F.bid * NWAVES + F.wave, NGW = F.G * NWAVES;
    for (int m = gw; m < nrows; m += NGW) {
        const bool isc = m >= ML;
        const int mi = row_mi(m);
        const float* sh = mod_ptr(F, l, mi, ch_shift); const float* sc = mod_ptr(F, l, mi, ch_scale);
        f32x4 v[4]; float s = 0.f;
        if (isc || xl != nullptr) {
            const float* xrow = (!isc) ? xl + (size_t)m * D : xc + (size_t)(m - ML) * D;
#pragma unroll
            for (int j = 0; j < 4; ++j) v[j] = *((const f32x4*)xrow + F.lane + 64 * j);
            if (!isc) {
#pragma unroll
                for (int j = 0; j < 4; ++j) *((u32x2*)(F.XB + (size_t)m * D) + F.lane + 64 * j) = (u32x2){cvt_pk_bf16(v[j].x, v[j].y), cvt_pk_bf16(v[j].z, v[j].w)};
            }
        } else {
#pragma unroll
            for (int j = 0; j < 4; ++j) { const u32x2 w = __builtin_nontemporal_load((const u32x2*)(F.XB + (size_t)m * D) + F.lane + 64 * j); v[j] = (f32x4){bflo(w.x), bfhi(w.x), bflo(w.y), bfhi(w.y)}; }
        }
        if (isc && nsplit > 0) {
            f32x4 a[4];
#pragma unroll
            for (int j = 0; j < 4; ++j) a[j] = (f32x4){0.f, 0.f, 0.f, 0.f};
            for (int sp = 0; sp < nsplit; ++sp) {
                const f32x4* pr = (const f32x4*)(pb + ((size_t)sp * MC + (m - ML)) * D) + F.lane;
#pragma unroll
                for (int j = 0; j < 4; ++j) a[j] += pr[64 * j];
            }
#pragma unroll
            for (int j = 0; j < 4; ++j) v[j] += a[j] * *((const f32x4*)pgate + F.lane + 64 * j);
        }
        if (isc && (nsplit > 0 || xc != xcw)) {
#pragma unroll
            for (int j = 0; j < 4; ++j) *((f32x4*)(xcw + (size_t)(m - ML) * D) + F.lane + 64 * j) = v[j];
        }
#pragma unroll
        for (int j = 0; j < 4; ++j) s += (v[j].x * v[j].x + v[j].y * v[j].y) + (v[j].z * v[j].z + v[j].w * v[j].w);
        const float rstd = 1.0f / sqrtf(wave_sum(s) * (1.0f / D) + 1e-6f);
        unsigned long long* o8 = (unsigned long long*)(F.H + (size_t)m * D) + F.lane;
#pragma unroll
        for (int j = 0; j < 4; ++j) {
            const f32x4 gg = *((const f32x4*)g + F.lane + 64 * j), s1 = *((const f32x4*)sh + F.lane + 64 * j), s2 = *((const f32x4*)sc + F.lane + 64 * j);
            const float a0 = (v[j].x * rstd * gg.x) * (1.0f + s2.x) + s1.x, a1 = (v[j].y * rstd * gg.y) * (1.0f + s2.y) + s1.y;
            const float a2 = (v[j].z * rstd * gg.z) * (1.0f + s2.z) + s1.z, a3 = (v[j].w * rstd * gg.w) * (1.0f + s2.w) + s1.w;
            o8[64 * j] = (unsigned long long)cvt_pk_bf16(a0, a1) | ((unsigned long long)cvt_pk_bf16(a2, a3) << 32);
        }
    }
}
__device__ __forceinline__ void final_norm(Frame& F) {
    const int gw = F.bid * NWAVES + F.wave, NGW = F.G * NWAVES; const float* g = F.in[I_GFINAL];
    for (int m = gw; m < ML; m += NGW) {
        float* orow = F.out + (size_t)m * D;
        f32x4 v[4]; float s = 0.f;
#pragma unroll
        for (int j = 0; j < 4; ++j) { const u32x2 w = *((const u32x2*)(F.XB + (size_t)m * D) + F.lane + 64 * j); v[j] = (f32x4){bflo(w.x), bfhi(w.x), bflo(w.y), bfhi(w.y)};
            s += (v[j].x * v[j].x + v[j].y * v[j].y) + (v[j].z * v[j].z + v[j].w * v[j].w); }
        const float rstd = 1.0f / sqrtf(wave_sum(s) * (1.0f / D) + 1e-6f);
#pragma unroll
        for (int j = 0; j < 4; ++j) { const f32x4 gg = *((const f32x4*)g + F.lane + 64 * j); *((f32x4*)orow + F.lane + 64 * j) = (f32x4){v[j].x * rstd * gg.x, v[j].y * rstd * gg.y, v[j].z * rstd * gg.z, v[j].w * rstd * gg.w}; }
    }
}

struct Order1 {
    int G, c; const char* H; const char* WT; int nctxg;
    __device__ __forceinline__ bool next(int i, Unit& u) const {
        u.lda = 1024; u.ldb = 1024; u.nt = 16;
        int L = i * G + c; if (L >= 924 + 264 + 8 + nctxg) return false;
        if (L >= 924 + 264 + 8) { L -= 924 + 264 + 8; u.pm = L >> 4; u.pn = L & 15; u.kind = 3; u.a = H + (size_t)(ML + u.pm * 256) * 2048; u.b = WT + (WT_G + (size_t)u.pn * 256 * 1024) * 2; return true; }
        if (L < 924) { pg8::tile_map(L, 132, 7, u.pm, u.pn); u.kind = 0; u.a = H + (size_t)u.pm * 256 * 2048; u.b = WT + (WT_NAT + (size_t)u.pn * 256 * 1024) * 2; return true; }
        L -= 924;
        if (L < 264) { u.pm = L / 132; u.pn = L % 132; u.kind = 1; u.a = WT + (WT_V + (size_t)u.pm * 256 * 1024) * 2; u.b = H + (size_t)u.pn * 256 * 2048; return true; }
        L -= 264; u.pm = L >> 2; u.pn = L & 3; u.kind = 2; u.a = WT + (WT_F + (size_t)u.pm * 256 * 1024) * 2; u.b = H + (size_t)(ML + u.pn * 256) * 2048; return true;
    }
};
struct Epi1 {
    static constexpr bool PERM = true;
    bf16_t* P; bf16_t* VT; bf16_t* ZC; const f32x2* rope; bf16_t* GC;
    __device__ __forceinline__ void rows(f32x4 (&acc)[2][2][4][2], int ai, int m, bf16_t* base, int ldc, int wr, int wc, int fr, int fq, bool do_rope, const f32x2 (&cs)[8], float qs, bool sig) const {
        const int rt = ai * 128 + wr * 64 + m * 16 + fr;
#pragma unroll
        for (int bj = 0; bj < 2; ++bj) {
            f32x4 v0 = acc[ai][bj][m][0], v1 = acc[ai][bj][m][1];
            if (do_rope) {
                const float sg = (fq < 2) ? -1.0f : 1.0f;
#pragma unroll
                for (int j = 0; j < 4; ++j) {
                    const float p0 = __shfl_xor(v0[j], 32), p1 = __shfl_xor(v1[j], 32);
                    v0[j] = v0[j] * cs[j].x + sg * p0 * cs[j].y; v1[j] = v1[j] * cs[4 + j].x + sg * p1 * cs[4 + j].y;
                }
            }
            v0 *= qs; v1 *= qs;
            if (sig) {
#pragma unroll
                for (int j = 0; j < 4; ++j) { v0[j] = sigmoidf_(v0[j]); v1[j] = sigmoidf_(v1[j]); }
            }
            u32x4 w; w.x = cvt_pk_bf16(v0[0], v0[1]); w.y = cvt_pk_bf16(v0[2], v0[3]); w.z = cvt_pk_bf16(v1[0], v1[1]); w.w = cvt_pk_bf16(v1[2], v1[3]);
            *(u32x4*)(base + (size_t)rt * ldc + bj * 128 + wc * 32 + 8 * fq) = w;
        }
        asm volatile("" ::: "memory");
    }
    __device__ __forceinline__ void load_cs(f32x2 (&cs)[8], int pos, int fq) const {
        const f32x4* tp = (const f32x4*)(rope + pos * 16 + 8 * (fq & 1));
#pragma unroll
        for (int q = 0; q < 4; ++q) { const f32x4 t = tp[q]; cs[2 * q] = (f32x2){t.x, t.y}; cs[2 * q + 1] = (f32x2){t.z, t.w}; }
    }
    __device__ __forceinline__ void operator()(f32x4 (&acc)[2][2][4][2], const Unit& u, int wr, int wc, int fr_, int fq_) const {
        int fr = fr_, fq = fq_; asm volatile("" : "+v"(fr), "+v"(fq));
        bf16_t* base; int ldc;
        if (u.kind == 0) { base = P + (size_t)u.pm * 256 * LDP + u.pn * 256; ldc = LDP; }
        else if (u.kind == 1) { base = VT + (size_t)u.pm * 256 * M + u.pn * 256; ldc = M; }
        else if (u.kind == 3) { base = GC + (size_t)u.pm * 256 * 4096 + u.pn * 256; ldc = 4096; }
        else { base = ZC + (size_t)u.pm * 256 * 1024 + u.pn * 256; ldc = 1024; }
        const bool do_rope = (u.kind == 0) && (u.pm < 128) && (u.pn < 4);
        const float qs = ((u.kind == 0) && (u.pn < 2)) ? 0.18033688011112042f : 1.0f;
        const bool sig = (u.kind == 3);
        if (do_rope && (wc & 1)) {
            f32x2 cs[4][8];
#pragma unroll
            for (int m = 0; m < 4; ++m) load_cs(cs[m], m * 16 + fr, fq);
#pragma unroll
            for (int m = 0; m < 4; ++m)
#pragma unroll
                for (int ai = 0; ai < 2; ++ai) rows(acc, ai, m, base, ldc, wr, wc, fr, fq, true, cs[m], qs, false);
        } else if (do_rope) {
            f32x2 cs[2][8];
#pragma unroll
            for (int ai = 0; ai < 2; ++ai) load_cs(cs[ai], (u.pm * 4 + ai * 2 + wr) & 127, fq);
#pragma unroll
            for (int ai = 0; ai < 2; ++ai)
#pragma unroll
                for (int m = 0; m < 4; ++m) rows(acc, ai, m, base, ldc, wr, wc, fr, fq, true, cs[ai], qs, false);
        } else {
            f32x2 cs[8];
#pragma unroll
            for (int j = 0; j < 8; ++j) cs[j] = (f32x2){1.f, 0.f};
#pragma unroll
            for (int ai = 0; ai < 2; ++ai)
#pragma unroll
                for (int m = 0; m < 4; ++m) rows(acc, ai, m, base, ldc, wr, wc, fr, fq, false, cs, qs, sig);
        }
    }
};
struct Order2 {
    int G, c; const char* H; const char* WT;
    __device__ __forceinline__ bool next(int i, Unit& u) const {
        u.lda = 1024; u.ldb = 64 * 1024; u.nt = 16;
        const int L = i * G + c; if (L >= 256) return false;
        const int n2 = L >> 2; u.pm = (L >> 1) & 1; u.pn = L & 1; u.kind = n2;
        u.a = WT + (WT_F + (size_t)u.pm * 256 * 1024) * 2; u.b = H + ((size_t)n2 + (size_t)64 * 256 * u.pn) * 2048; return true;
    }
};
struct EpiPlain {
    static constexpr bool PERM = true;
    bf16_t* base; int ldc; size_t kstride; int relu2;
    __device__ __forceinline__ void operator()(f32x4 (&acc)[2][2][4][2], const Unit& u, int wr, int wc, int fr_, int fq_) const {
        int fr = fr_, fq = fq_; asm volatile("" : "+v"(fr), "+v"(fq));
        bf16_t* b0 = base + (size_t)u.kind * kstride + (size_t)u.pm * 256 * ldc + u.pn * 256;
#pragma unroll
        for (int ai = 0; ai < 2; ++ai)
#pragma unroll
            for (int m = 0; m < 4; ++m) {
                const int rt = ai * 128 + wr * 64 + m * 16 + fr;
#pragma unroll
                for (int bj = 0; bj < 2; ++bj) {
                    f32x4 v0 = acc[ai][bj][m][0], v1 = acc[ai][bj][m][1];
                    if (relu2) {
#pragma unroll
                        for (int j = 0; j < 4; ++j) { const float a = fmaxf(v0[j], 0.f), b = fmaxf(v1[j], 0.f); v0[j] = a * a; v1[j] = b * b; }
                    }
                    u32x4 w; w.x = cvt_pk_bf16(v0[0], v0[1]); w.y = cvt_pk_bf16(v0[2], v0[3]); w.z = cvt_pk_bf16(v1[0], v1[1]); w.w = cvt_pk_bf16(v1[2], v1[3]);
                    *(u32x4*)(b0 + (size_t)rt * ldc + bj * 128 + wc * 32 + 8 * fq) = w;
                }
            }
    }
};
struct OrderN {
    int G, c, nM, nN, nbr, lda, ldb; const char* A0; const char* B0; size_t astride, bstride;
    __device__ __forceinline__ bool next(int i, Unit& u) const {
        u.lda = lda; u.ldb = ldb; u.nt = lda / 64;
        int L = i * G + c; const int per = nM * nN; if (L >= per * nbr) return false;
        const int br = L / per; L -= br * per;
        pg8::tile_map(L, nM, nN, u.pm, u.pn); u.kind = br;
        u.a = A0 + br * astride + (size_t)u.pm * 256 * lda * 2; u.b = B0 + br * bstride + (size_t)u.pn * 256 * ldb * 2; return true;
    }
};
struct OrderG {
    int G, c, nctx; const char* H; const char* WG;
    __device__ __forceinline__ bool next(int i, Unit& u) const {
        u.lda = 1024; u.ldb = 1024; u.nt = 16;
        const int ng = (512 - c + G - 1) / G;
        if (i < 4 * ng) { const int t = (i >> 2) * G + c; int pno; pg8::tile_map(t, 128, 4, u.pm, pno); const int b = i & 3; u.kind = b; u.pn = pno;
            u.a = H + (size_t)u.pm * 256 * 2048; u.b = WG + (size_t)(b * 4 + pno) * 256 * 2048; return true; }
        const int j = (i - 4 * ng) * G + c; if (j >= nctx) return false;
        const int b = j & 3, pno = (j >> 2) & 3; u.pm = 128 + (j >> 4); u.pn = pno; u.kind = 4 + b;
        u.a = H + (size_t)u.pm * 256 * 2048; u.b = WG + (size_t)(b * 4 + pno) * 256 * 2048; return true;
    }
};
struct EpiGate {
    static constexpr bool PERM = true;
    const bf16_t* Y; bf16_t* MG;
    __device__ __forceinline__ void operator()(f32x4 (&acc)[2][2][4][2], const Unit& u, int wr, int wc, int fr_, int fq_) const {
        int fr = fr_, fq = fq_; asm volatile("" : "+v"(fr), "+v"(fq));
        const int b = u.kind & 3; const bool inplace = u.kind >= 4;
#pragma unroll
        for (int ai = 0; ai < 2; ++ai)
#pragma unroll
            for (int m = 0; m < 4; ++m) {
                const size_t row = (size_t)u.pm * 256 + ai * 128 + wr * 64 + m * 16 + fr;
#pragma unroll
                for (int bj = 0; bj < 2; ++bj) {
                    const int col = u.pn * 256 + bj * 128 + wc * 32 + 8 * fq;
                    const u32x4 yv = __builtin_nontemporal_load((const u32x4*)(Y + row * 4096 + b * 1024 + col));
                    u32x4 mv = (u32x4){0u, 0u, 0u, 0u};
                    if (b > 0 && !inplace) mv = *(const u32x4*)(MG + row * 1024 + col);
                    const f32x4 v0 = acc[ai][bj][m][0], v1 = acc[ai][bj][m][1];
                    float r[8];
                    r[0] = sigmoidf_(v0[0]) * bflo(yv.x) + bflo(mv.x); r[1] = sigmoidf_(v0[1]) * bfhi(yv.x) + bfhi(mv.x);
                    r[2] = sigmoidf_(v0[2]) * bflo(yv.y) + bflo(mv.y); r[3] = sigmoidf_(v0[3]) * bfhi(yv.y) + bfhi(mv.y);
                    r[4] = sigmoidf_(v1[0]) * bflo(yv.z) + bflo(mv.z); r[5] = sigmoidf_(v1[1]) * bfhi(yv.z) + bfhi(mv.z);
                    r[6] = sigmoidf_(v1[2]) * bflo(yv.w) + bflo(mv.w); r[7] = sigmoidf_(v1[3]) * bfhi(yv.w) + bfhi(mv.w);
                    u32x4 w; w.x = cvt_pk_bf16(r[0], r[1]); w.y = cvt_pk_bf16(r[2], r[3]); w.z = cvt_pk_bf16(r[4], r[5]); w.w = cvt_pk_bf16(r[6], r[7]);
                    if (inplace) *(u32x4*)(Y + row * 4096 + b * 1024 + col) = w; else *(u32x4*)(MG + row * 1024 + col) = w;
                }
            }
    }
};
struct OrderF {
    int G, c, nctx; const char* H; const char* WT; const char* R2;
    __device__ __forceinline__ bool next(int i, Unit& u) const {
        const int ng = (512 - c + G - 1) / G;
        int pm, pno, b, isg; bool ctx;
        if (i < 8 * ng) { const int t = (i >> 3) * G + c; pg8::tile_map(t, 128, 4, pm, pno); const int sub = i & 7; b = sub >> 1; isg = sub & 1; ctx = false; }
        else { const int ii = i - 8 * ng, pr = ii * G + c; if (pr >= nctx) return false; isg = 0; b = pr & 3; pno = (pr >> 2) & 3; pm = 128 + (pr >> 4); ctx = true; }
        u.pm = pm; u.pn = pno;
        if (isg) { u.kind = (ctx ? 4 : 0) + b; u.a = H + (size_t)pm * 256 * 2048; u.lda = 1024; u.b = WT + (WT_G + (size_t)(b * 4 + pno) * 256 * 1024) * 2; u.ldb = 1024; u.nt = 16; }
        else {
            const int Kb = (b == 0) ? 512 : 256;
            const size_t aoffb = (b == 0) ? R2_ATTN : (b == 1 ? R2_POOL : (b == 2 ? R2_FOUR : R2_CONV));
            const size_t woff = (b == 0) ? WT_BA : (b == 1 ? WT_BP : (b == 2 ? WT_BF : WT_BC));
            u.kind = (ctx ? 12 : 8) + b; u.a = R2 + aoffb + (size_t)pm * 256 * Kb * 2; u.lda = Kb; u.b = WT + (woff + (size_t)pno * 256 * Kb) * 2; u.ldb = Kb; u.nt = Kb / 64;
        }
        return true;
    }
};
struct EpiFused {
    static constexpr bool PERM = true;
    bf16_t* MG; bf16_t* GYc; unsigned char* scr; const bf16_t* GC;
    __device__ __forceinline__ void operator()(f32x4 (&acc)[2][2][4][2], const Unit& u, int wr, int wc, int fr_, int fq_) const {
        int fr = fr_, fq = fq_; asm volatile("" : "+v"(fr), "+v"(fq));
        u32x4* slot = (u32x4*)scr + ((wr * 4 + wc) * 64 + fq * 16 + fr);
        if (u.kind >= 12) {
            const int b = u.kind & 3;
#pragma unroll
            for (int ai = 0; ai < 2; ++ai) {
                u32x4 gq[4][2];
#pragma unroll
                for (int m = 0; m < 4; ++m)
#pragma unroll
                    for (int bj = 0; bj < 2; ++bj)
                        gq[m][bj] = *(const u32x4*)(GC + ((size_t)(u.pm - 128) * 256 + ai * 128 + wr * 64 + m * 16 + fr) * 4096 + b * 1024 + u.pn * 256 + bj * 128 + wc * 32 + 8 * fq);
#pragma unroll
                for (int m = 0; m < 4; ++m)
#pragma unroll
                    for (int bj = 0; bj < 2; ++bj) {
                        const size_t off = ((size_t)(u.pm - 128) * 256 + ai * 128 + wr * 64 + m * 16 + fr) * 4096 + b * 1024 + u.pn * 256 + bj * 128 + wc * 32 + 8 * fq;
                        const u32x4 gv = gq[m][bj];
                        const f32x4 v0 = acc[ai][bj][m][0], v1 = acc[ai][bj][m][1];
                        u32x4 w; w.x = cvt_pk_bf16(v0[0] * bflo(gv.x), v0[1] * bfhi(gv.x)); w.y = cvt_pk_bf16(v0[2] * bflo(gv.y), v0[3] * bfhi(gv.y));
                        w.z = cvt_pk_bf16(v1[0] * bflo(gv.z), v1[1] * bfhi(gv.z)); w.w = cvt_pk_bf16(v1[2] * bflo(gv.w), v1[3] * bfhi(gv.w));
                        *(u32x4*)(GYc + off) = w;
                    }
                asm volatile("" ::: "memory");
            }
            return;
        }
        if (u.kind >= 8) {
#pragma unroll
            for (int ai = 0; ai < 2; ++ai)
#pragma unroll
                for (int m = 0; m < 4; ++m)
#pragma unroll
                    for (int bj = 0; bj < 2; ++bj) {
                        const f32x4 v0 = acc[ai][bj][m][0], v1 = acc[ai][bj][m][1];
                        u32x4 w; w.x = cvt_pk_bf16(v0[0], v0[1]); w.y = cvt_pk_bf16(v0[2], v0[3]); w.z = cvt_pk_bf16(v1[0], v1[1]); w.w = cvt_pk_bf16(v1[2], v1[3]);
                        slot[((ai * 4 + m) * 2 + bj) * 512] = w;
                    }
            return;
        }
        const int b = u.kind & 3; const bool inplace = u.kind >= 4;
#pragma unroll
        for (int ai = 0; ai < 2; ++ai) {
            u32x4 yv[4][2], mv[4][2];
#pragma unroll
            for (int m = 0; m < 4; ++m)
#pragma unroll
                for (int bj = 0; bj < 2; ++bj) {
                    yv[m][bj] = slot[((ai * 4 + m) * 2 + bj) * 512];
                    mv[m][bj] = (u32x4){0u, 0u, 0u, 0u};
                    if (b > 0 && !inplace) mv[m][bj] = *(const u32x4*)(MG + ((size_t)u.pm * 256 + ai * 128 + wr * 64 + m * 16 + fr) * 1024 + u.pn * 256 + bj * 128 + wc * 32 + 8 * fq);
                }
#pragma unroll
            for (int m = 0; m < 4; ++m) {
                const size_t row = (size_t)u.pm * 256 + ai * 128 + wr * 64 + m * 16 + fr;
#pragma unroll
                for (int bj = 0; bj < 2; ++bj) {
                    const int col = u.pn * 256 + bj * 128 + wc * 32 + 8 * fq;
                    const u32x4 y4 = yv[m][bj], m4 = mv[m][bj];
                    const f32x4 v0 = acc[ai][bj][m][0], v1 = acc[ai][bj][m][1];
                    float r[8];
                    r[0] = sigmoidf_(v0[0]) * bflo(y4.x) + bflo(m4.x); r[1] = sigmoidf_(v0[1]) * bfhi(y4.x) + bfhi(m4.x);
                    r[2] = sigmoidf_(v0[2]) * bflo(y4.y) + bflo(m4.y); r[3] = sigmoidf_(v0[3]) * bfhi(y4.y) + bfhi(m4.y);
                    r[4] = sigmoidf_(v1[0]) * bflo(y4.z) + bflo(m4.z); r[5] = sigmoidf_(v1[1]) * bfhi(y4.z) + bfhi(m4.z);
                    r[6] = sigmoidf_(v1[2]) * bflo(y4.w) + bflo(m4.w); r[7] = sigmoidf_(v1[3]) * bfhi(y4.w) + bfhi(m4.w);
                    u32x4 w; w.x = cvt_pk_bf16(r[0], r[1]); w.y = cvt_pk_bf16(r[2], r[3]); w.z = cvt_pk_bf16(r[4], r[5]); w.w = cvt_pk_bf16(r[6], r[7]);
                    if (inplace) *(u32x4*)(GYc + (row - ML) * 4096 + b * 1024 + col) = w; else *(u32x4*)(MG + row * 1024 + col) = w;
                }
            }
            asm volatile("" ::: "memory");
        }
    }
};
struct OrderMini {
    int G, c, nsplit, kchunk, lda, ldb, bwrap; const char* A0; const char* B0;
    __device__ __forceinline__ bool next(int i, Unit& u) const {
        u.lda = lda; u.ldb = ldb; u.nt = kchunk / 64;
        const int j = i * G + c; if (j >= 16 * nsplit) return false;
        const int kc = j >> 4; u.pm = (j >> 2) & 3; u.pn = j & 3; u.kind = kc;
        u.a = A0 + ((size_t)u.pm * 256 * lda + (size_t)kc * kchunk) * 2; u.b = B0 + ((size_t)u.pn * 256 * ldb + (size_t)((kc * kchunk) % bwrap)) * 2; return true;
    }
};
struct EpiPartial {
    static constexpr bool PERM = false;
    float* PB;
    __device__ __forceinline__ void operator()(f32x4 (&acc)[2][2][4][2], const Unit& u, int wr, int wc, int fr_, int fq_) const {
        int fr = fr_, fq = fq_; asm volatile("" : "+v"(fr), "+v"(fq));
        float* base = PB + ((size_t)u.kind * MC + (size_t)u.pm * 256) * D + u.pn * 256 + wc * 32 + 4 * fq;
#pragma unroll
        for (int ai = 0; ai < 2; ++ai)
#pragma unroll
            for (int m = 0; m < 4; ++m) {
                const size_t ro = (size_t)(ai * 128 + wr * 64 + m * 16 + fr) * D;
#pragma unroll
                for (int bj = 0; bj < 2; ++bj)
#pragma unroll
                    for (int n = 0; n < 2; ++n) *(f32x4*)(base + ro + bj * 128 + n * 16) = acc[ai][bj][m][n];
            }
    }
};
struct EpiRes {
    static constexpr bool PERM = true;
    bf16_t* XB; const float* MODL; int chunk;
    __device__ __forceinline__ void operator()(f32x4 (&acc)[2][2][4][2], const Unit& u, int wr, int wc, int fr_, int fq_) const {
        int fr = fr_, fq = fq_; asm volatile("" : "+v"(fr), "+v"(fq));
        const int mi = tile_mi(u.pm);
        const float* gt = MODL + ((size_t)mi * 6 + chunk) * D + u.pn * 256 + wc * 32 + 8 * fq;
        bf16_t* xp = XB + (size_t)u.pm * 256 * D + u.pn * 256 + wc * 32 + 8 * fq;
        f32x4 gv[2][2];
#pragma unroll
        for (int bj = 0; bj < 2; ++bj)
#pragma unroll
            for (int n = 0; n < 2; ++n) gv[bj][n] = *(const f32x4*)(gt + bj * 128 + n * 4);
#pragma unroll
        for (int ai = 0; ai < 2; ++ai) {
            u32x4 xo[4][2];
#pragma unroll
            for (int m = 0; m < 4; ++m)
#pragma unroll
                for (int bj = 0; bj < 2; ++bj) xo[m][bj] = *(const u32x4*)(xp + (size_t)(ai * 128 + wr * 64 + m * 16 + fr) * D + bj * 128);
#pragma unroll
            for (int m = 0; m < 4; ++m) {
                const size_t ro = (size_t)(ai * 128 + wr * 64 + m * 16 + fr) * D;
#pragma unroll
                for (int bj = 0; bj < 2; ++bj) {
                    const u32x4 x0 = xo[m][bj];
                    const f32x4 a0 = acc[ai][bj][m][0] * gv[bj][0], a1 = acc[ai][bj][m][1] * gv[bj][1];
                    u32x4 w; w.x = cvt_pk_bf16(bflo(x0.x) + a0[0], bfhi(x0.x) + a0[1]); w.y = cvt_pk_bf16(bflo(x0.y) + a0[2], bfhi(x0.y) + a0[3]);
                    w.z = cvt_pk_bf16(bflo(x0.z) + a1[0], bfhi(x0.z) + a1[1]); w.w = cvt_pk_bf16(bflo(x0.w) + a1[2], bfhi(x0.w) + a1[3]);
                    *(u32x4*)(xp + ro + bj * 128) = w;
                }
            }
            asm volatile("" ::: "memory");
        }
    }
};

constexpr int AT_STR = 144, AT_TILE = 64 * AT_STR, AT_BUF = 2 * AT_TILE, AT_RPB = 5 * AT_BUF;
template <bool CTX>
__device__ __forceinline__ void attn_step(const LAS unsigned char* kt, const LAS unsigned char* vt, const LAS float* rpb, const bf16x8 (&q)[2], f32x4 (&o)[4], float& mrun, float& lrun,
                                          const int g, const int drow, const int fr, const int fq) {
    constexpr int NTL = CTX ? 4 : 2;
    const int kc0 = CTX ? 0 : (g == 0 ? 0 : (g == 1 ? 8 : (g == 2 ? 24 : 32)));
    f32x4 s[NTL];
#pragma unroll
    for (int t = 0; t < NTL; ++t) {
        s[t] = (f32x4){0.f, 0.f, 0.f, 0.f};
#pragma unroll
        for (int kb = 0; kb < 2; ++kb) { const bf16x8 ka = *(const LAS bf16x8*)(kt + (kc0 + 16 * t + fr) * AT_STR + kb * 64 + fq * 16); s[t] = MFMA16(ka, q[kb], s[t]); }
    }
    if (!CTX) {
        const int c = 16 * g + fr; const int cs = min(max(c - 8, 0), 48); const int delta = cs - kc0;
        bool sel[4];
#pragma unroll
        for (int r = 0; r < 4; ++r) {
            const int i = 4 * fq + r; sel[r] = (i >= delta);
            const int kc = kc0 + i + (sel[r] ? 0 : 16);
            s[0][r] = (sel[r] ? s[0][r] : s[1][r]) + rpb[drow * 31 + (kc - c + 15)];
        }
        float mx = fmaxf(fmaxf(s[0][0], s[0][1]), fmaxf(s[0][2], s[0][3]));
        mx = fmaxf(mx, __shfl_xor(mx, 16)); mx = fmaxf(mx, __shfl_xor(mx, 32));
        const float mn = fmaxf(mrun, mx), alpha = __builtin_amdgcn_exp2f(mrun - mn);
        float ps = 0.f;
#pragma unroll
        for (int r = 0; r < 4; ++r) { s[0][r] = __builtin_amdgcn_exp2f(s[0][r] - mn); ps += s[0][r]; }
        lrun = lrun * alpha + ps; mrun = mn;
#pragma unroll
        for (int dt = 0; dt < 4; ++dt) o[dt] *= alpha;
        u32x4 pw;
        pw.x = cvt_pk_bf16(sel[0] ? s[0][0] : 0.f, sel[1] ? s[0][1] : 0.f); pw.y = cvt_pk_bf16(sel[2] ? s[0][2] : 0.f, sel[3] ? s[0][3] : 0.f);
        pw.z = cvt_pk_bf16(sel[0] ? 0.f : s[0][0], sel[1] ? 0.f : s[0][1]); pw.w = cvt_pk_bf16(sel[2] ? 0.f : s[0][2], sel[3] ? 0.f : s[0][3]);
        const bf16x8 pk = __builtin_bit_cast(bf16x8, pw);
#pragma unroll
        for (int dt = 0; dt < 4; ++dt) {
            const LAS unsigned char* vp = vt + (16 * dt + fr) * AT_STR + (kc0 + 4 * fq) * 2;
            const u32x2 lo = *(const LAS u32x2*)vp, hi = *(const LAS u32x2*)(vp + 32);
            const u32x4 vw = (u32x4){lo.x, lo.y, hi.x, hi.y};
            o[dt] = MFMA16(__builtin_bit_cast(bf16x8, vw), pk, o[dt]);
        }
        return;
    }
    float mx = s[0][0];
#pragma unroll
    for (int t = 0; t < NTL; ++t)
#pragma unroll
        for (int r = 0; r < 4; ++r) mx = fmaxf(mx, s[t][r]);
    mx = fmaxf(mx, __shfl_xor(mx, 16)); mx = fmaxf(mx, __shfl_xor(mx, 32));
    const float mn = fmaxf(mrun, mx), alpha = __builtin_amdgcn_exp2f(mrun - mn);
    float ps = 0.f;
#pragma unroll
    for (int t = 0; t < NTL; ++t)
#pragma unroll
        for (int r = 0; r < 4; ++r) { s[t][r] = __builtin_amdgcn_exp2f(s[t][r] - mn); ps += s[t][r]; }
    lrun = lrun * alpha + ps; mrun = mn;
#pragma unroll
    for (int dt = 0; dt < 4; ++dt) o[dt] *= alpha;
#pragma unroll
    for (int k2 = 0; k2 < NTL / 2; ++k2) {
        u32x4 pw; pw.x = cvt_pk_bf16(s[2 * k2][0], s[2 * k2][1]); pw.y = cvt_pk_bf16(s[2 * k2][2], s[2 * k2][3]); pw.z = cvt_pk_bf16(s[2 * k2 + 1][0], s[2 * k2 + 1][1]); pw.w = cvt_pk_bf16(s[2 * k2 + 1][2], s[2 * k2 + 1][3]);
        const bf16x8 pk = __builtin_bit_cast(bf16x8, pw);
#pragma unroll
        for (int dt = 0; dt < 4; ++dt) {
            const LAS unsigned char* vp = vt + (16 * dt + fr) * AT_STR + (kc0 + 32 * k2 + 4 * fq) * 2;
            const u32x2 lo = *(const LAS u32x2*)vp, hi = *(const LAS u32x2*)(vp + 32);
            const u32x4 vw = (u32x4){lo.x, lo.y, hi.x, hi.y};
            o[dt] = MFMA16(__builtin_bit_cast(bf16x8, vw), pk, o[dt]);
        }
    }
}
__device__ __forceinline__ void attn_unit(Frame& F, int l, int b, int h, int rb) {
    const bool cu = rb < 0;
    const int w = F.wave, fr = F.lane & 15, fq = F.lane >> 4, gh = w & 1;
    const int r0 = cu ? 0 : 4 * rb;
    const int lo = min(max(r0 - 4, 0), 120), rs3 = min(max(r0 - 1, 0), 120);
    const int span = cu ? 0 : rs3 - lo;
    const int nwin = cu ? 0 : span + 8, ntot = nwin + 4, nsteps = cu ? 4 : 12;
    const int qr = r0 + (w >> 1), rs = min(max(qr - 4, 0), 120), di = rs - lo;
    const size_t qrow0 = cu ? (size_t)(ML + b * 256 + 32 * w) : (size_t)(b * SEQ + qr * 64 + 32 * gh);
    LAS float* rpb = (LAS float*)(F.lds + AT_RPB);
    __syncthreads();
    if (!cu) for (int i = F.tid; i < 465; i += NT) rpb[i] = 1.4426950408889634f * F.in[I_RPB][((size_t)l * 8 + h) * 465 + i];
    bf16x8 q[2][2]; f32x4 o[2][4]; float mrun[2], lrun[2];
#pragma unroll
    for (int g = 0; g < 2; ++g) {
        mrun[g] = -1e30f; lrun[g] = 0.f;
#pragma unroll
        for (int dt = 0; dt < 4; ++dt) o[g][dt] = (f32x4){0.f, 0.f, 0.f, 0.f};
#pragma unroll
        for (int kb = 0; kb < 2; ++kb) q[g][kb] = *(const bf16x8*)(F.P + (qrow0 + 16 * g + fr) * LDP + PQ + h * 64 + 32 * kb + 8 * fq);
    }
    const int srow = F.tid >> 3, sch = F.tid & 7;
#define AT_ROWBASE(x) (((x) < nwin) ? (size_t)(b * SEQ + (lo + (x)) * 64) : (size_t)(ML + b * 256 + 64 * ((x) - nwin)))
#define AT_SLOT(x) ((x) - 5 * (((x) * 13) >> 6))
#define AT_LOADX(kr_, vr_, x) do { const size_t rb0 = AT_ROWBASE(x); \
        kr_ = *(const u32x4*)(F.P + (rb0 + srow) * LDP + PK + h * 64 + sch * 8); vr_ = *(const u32x4*)(F.VT + (size_t)(h * 64 + srow) * M + rb0 + sch * 8); } while (0)
#define AT_WRITEX(kr_, vr_, x) do { LAS unsigned char* _d = F.lds + AT_SLOT(x) * AT_BUF + srow * AT_STR + sch * 16; *(LAS u32x4*)_d = kr_; *(LAS u32x4*)(_d + AT_TILE) = vr_; } while (0)
    {
        u32x4 k0[4], v0[4];
#pragma unroll
        for (int j = 0; j < 4; ++j) if (j <= span) AT_LOADX(k0[j], v0[j], j);
#pragma unroll
        for (int j = 0; j < 4; ++j) if (j <= span) AT_WRITEX(k0[j], v0[j], j);
    }
    __syncthreads();
    u32x4 kreg, vreg;
    for (int t = 0; t < nsteps; ++t) {
        const int xn = span + t + 1;
        if (xn < ntot) AT_LOADX(kreg, vreg, xn);
        if (!cu && t < 8) {
            const int x = di + t;
            const LAS unsigned char* kt = F.lds + AT_SLOT(x) * AT_BUF; const LAS unsigned char* vt = kt + AT_TILE;
            const int drow = (lo + x) - qr + 7;
            attn_step<false>(kt, vt, rpb, q[0], o[0], mrun[0], lrun[0], 2 * gh, drow, fr, fq); attn_step<false>(kt, vt, rpb, q[1], o[1], mrun[1], lrun[1], 2 * gh + 1, drow, fr, fq);
        } else {
            const int x = cu ? t : nwin + t - 8;
            const LAS unsigned char* kt = F.lds + AT_SLOT(x) * AT_BUF; const LAS unsigned char* vt = kt + AT_TILE;
            attn_step<true>(kt, vt, rpb, q[0], o[0], mrun[0], lrun[0], 0, 0, fr, fq); attn_step<true>(kt, vt, rpb, q[1], o[1], mrun[1], lrun[1], 0, 0, fr, fq);
        }
        if (xn < ntot) AT_WRITEX(kreg, vreg, xn);
        __syncthreads();
    }
#undef AT_LOADX
#undef AT_WRITEX
#undef AT_SLOT
#undef AT_ROWBASE
#pragma unroll
    for (int g = 0; g < 2; ++g) {
        float lt = lrun[g]; lt += __shfl_xor(lt, 16); lt += __shfl_xor(lt, 32);
        const float inv = 1.0f / lt;
        bf16_t* op = F.ATTN + (qrow0 + 16 * g + fr) * 512 + h * 64 + 4 * fq;
#pragma unroll
        for (int dt = 0; dt < 4; ++dt) { const f32x4 v = o[g][dt] * inv; u32x2 wv; wv.x = cvt_pk_bf16(v[0], v[1]); wv.y = cvt_pk_bf16(v[2], v[3]); *(u32x2*)(op + 16 * dt) = wv; }
    }
}

constexpr int SA_ROW = 272, SA_BUF = 256 * SA_ROW;
__device__ __forceinline__ void four_stageA(Frame& F) {
    const int fr = F.lane & 15, fq = F.lane >> 4, w = F.wave;
    const bf16_t* __restrict__ C128 = F.DFT + DFT_C128 / 2; const bf16_t* __restrict__ S128 = F.DFT + DFT_S128 / 2;
    const bf16_t* __restrict__ ZAp = F.ZA; const f32x2* __restrict__ TWp = F.TW; bf16_t* __restrict__ TPp = F.TP;
    const bf16x8 sgn = (bf16x8){(short)0x8000, (short)0x8000, (short)0x8000, (short)0x8000, (short)0x8000, (short)0x8000, (short)0x8000, (short)0x8000};
    u32x4 st[8];
#define SA_LOAD(uu) do { const int _cb = (uu) & 15, _nb = ((uu) >> 4) & 7, _b = (uu) >> 7; \
        _Pragma("unroll") for (int it = 0; it < 8; ++it) { const int qd = F.tid + it * NT, rr = qd >> 4, ch = qd & 15, j = rr >> 5, cr = rr & 31; \
            st[it] = *(const u32x4*)(ZAp + ((size_t)((8 * _nb + j) * 512 + (cr >> 4) * 256 + 16 * _cb + (cr & 15)) * 512 + 128 * _b + ch * 8)); } } while (0)
#define SA_WRITE(buf) do { _Pragma("unroll") for (int it = 0; it < 8; ++it) { const int qd = F.tid + it * NT, rr = qd >> 4, ch = qd & 15; \
            *(LAS u32x4*)(F.lds + (buf) * SA_BUF + rr * SA_ROW + ch * 16) = st[it]; } } while (0)
    __syncthreads();
    if (F.bid < 512) { SA_LOAD(F.bid); SA_WRITE(0); }
    __syncthreads();
    int it_u = 0;
    for (int u = F.bid; u < 512; u += F.G, ++it_u) {
        const int cb = u & 15, nb = (u >> 4) & 7, b = u >> 7;
        const bool has_next = (u + F.G) < 512;
        if (has_next) SA_LOAD(u + F.G);
        const LAS unsigned char* zb = F.lds + (it_u & 1) * SA_BUF;
        f32x4 Tr[8], Ti[8];
#pragma unroll
        for (int j = 0; j < 8; ++j) { Tr[j] = (f32x4){0.f, 0.f, 0.f, 0.f}; Ti[j] = (f32x4){0.f, 0.f, 0.f, 0.f}; }
#pragma unroll
        for (int kk = 0; kk < 4; ++kk) {
            const bf16x8 Cf = *(const bf16x8*)(C128 + (16 * w + fr) * 128 + 32 * kk + 8 * fq);
            const bf16x8 Sf = *(const bf16x8*)(S128 + (16 * w + fr) * 128 + 32 * kk + 8 * fq);
            const bf16x8 nSf = Sf ^ sgn;
#pragma unroll
            for (int j = 0; j < 8; ++j) {
                const bf16x8 Zr = *(const LAS bf16x8*)(zb + (j * 32 + fr) * SA_ROW + (32 * kk + 8 * fq) * 2);
                const bf16x8 Zi = *(const LAS bf16x8*)(zb + (j * 32 + 16 + fr) * SA_ROW + (32 * kk + 8 * fq) * 2);
                Tr[j] = MFMA16(Cf, Zr, Tr[j]); Tr[j] = MFMA16(Sf, Zi, Tr[j]); Ti[j] = MFMA16(Cf, Zi, Ti[j]); Ti[j] = MFMA16(nSf, Zr, Ti[j]);
            }
        }
#pragma unroll
        for (int r = 0; r < 4; ++r) {
            const int k1 = 16 * w + 4 * fq + r;
            float tr[8], ti[8];
#pragma unroll
            for (int j = 0; j < 8; ++j) { const f32x2 t = TWp[k1 * (8 * nb + j)]; tr[j] = Tr[j][r] * t.x + Ti[j][r] * t.y; ti[j] = Ti[j][r] * t.x - Tr[j][r] * t.y; }
            bf16_t* tp = TPp + ((size_t)((b * 128 + k1) * 2) * 256 + 16 * cb + fr) * 64 + 8 * nb;
            u32x4 wv; wv.x = cvt_pk_bf16(tr[0], tr[1]); wv.y = cvt_pk_bf16(tr[2], tr[3]); wv.z = cvt_pk_bf16(tr[4], tr[5]); wv.w = cvt_pk_bf16(tr[6], tr[7]);
            *(u32x4*)tp = wv;
            wv.x = cvt_pk_bf16(ti[0], ti[1]); wv.y = cvt_pk_bf16(ti[2], ti[3]); wv.z = cvt_pk_bf16(ti[4], ti[5]); wv.w = cvt_pk_bf16(ti[6], ti[7]);
            *(u32x4*)(tp + 256 * 64) = wv;
        }
        if (has_next) SA_WRITE((it_u + 1) & 1);
        __syncthreads();
    }
#undef SA_LOAD
#undef SA_WRITE
}
__device__ __forceinline__ void four_stageB(Frame& F) {
    const int gw = F.bid * NWAVES + F.wave, NGW = F.G * NWAVES, fr = F.lane & 15, fq = F.lane >> 4;
    const bf16_t* __restrict__ G64 = F.DFT + DFT_C64 / 2;
    const bf16_t* __restrict__ G256 = F.DFT + DFT_C256 / 2;
    const bf16_t* __restrict__ TPr = F.TP; const bf16_t* __restrict__ ZCr = F.ZC; bf16_t* __restrict__ FO = F.FOURO;
    for (int u = gw; u < 8192; u += NGW) {
        const int cb = u & 15, inst = u >> 4, b = inst >> 7, k1 = inst & 127;
        f32x4 acc[4];
#pragma unroll
        for (int t = 0; t < 4; ++t) acc[t] = (f32x4){0.f, 0.f, 0.f, 0.f};
#pragma unroll
        for (int ri = 0; ri < 2; ++ri)
#pragma unroll
            for (int kk = 0; kk < 2; ++kk) {
                const bf16x8 A = __builtin_nontemporal_load((const bf16x8*)(TPr + ((size_t)(inst * 2 + ri) * 256 + 16 * cb + fr) * 64 + 32 * kk + 8 * fq));
#pragma unroll
                for (int t = 0; t < 4; ++t) { const bf16x8 B = *(const bf16x8*)(G64 + ri * 4096 + (16 * t + fr) * 64 + 32 * kk + 8 * fq); acc[t] = MFMA16(A, B, acc[t]); }
            }
        const float sc = 0.011048543456039806f;
#pragma unroll
        for (int t = 0; t < 4; ++t) {
            const f32x4 v = acc[t] * sc; u32x2 wv; wv.x = cvt_pk_bf16(v[0], v[1]); wv.y = cvt_pk_bf16(v[2], v[3]);
            *(u32x2*)(FO + (size_t)(b * SEQ + k1 + 128 * (16 * t + fr)) * 256 + 16 * cb + 4 * fq) = wv;
        }
    }
    for (int u = gw; u < 1024; u += NGW) {
        const int kt = u & 15, cb = (u >> 4) & 15, b = u >> 8;
        bf16x8 A[2][8], B[2][8];
#pragma unroll
        for (int ri = 0; ri < 2; ++ri)
#pragma unroll
            for (int kk = 0; kk < 8; ++kk) {
                A[ri][kk] = *(const bf16x8*)(ZCr + (size_t)(ri * 256 + 16 * cb + fr) * 1024 + b * 256 + 32 * kk + 8 * fq);
                B[ri][kk] = *(const bf16x8*)(G256 + ri * 65536 + (16 * kt + fr) * 256 + 32 * kk + 8 * fq);
            }
        f32x4 acc = (f32x4){0.f, 0.f, 0.f, 0.f};
#pragma unroll
        for (int ri = 0; ri < 2; ++ri)
#pragma unroll
            for (int kk = 0; kk < 8; ++kk) acc = MFMA16(A[ri][kk], B[ri][kk], acc);
        const f32x4 v = acc * 0.0625f; u32x2 wv; wv.x = cvt_pk_bf16(v[0], v[1]); wv.y = cvt_pk_bf16(v[2], v[3]);
        *(u32x2*)(FO + (size_t)(ML + b * 256 + 16 * kt + fr) * 256 + 16 * cb + 4 * fq) = wv;
    }
}

constexpr int PL_DSTR = 264;
template <int GI>
__device__ __forceinline__ void pool_diffs(const LAS float* us, LAS bf16_t* db, int ch, int half, int R0, int S0, int S1) {
    constexpr int LO = 1 << GI, HI = LO - 1;
    float v[47];
#pragma unroll
    for (int i = 0; i < 47; ++i) v[i] = us[(half * 32 + i) * 256 + ch];
    float s = 0.f;
#pragma unroll
    for (int i = 8 - LO; i <= 8 + HI; ++i) s += v[i];
#pragma unroll
    for (int tt = 0; tt < 32; ++tt) {
        if (tt > 0) s += v[tt + 8 + HI] - v[tt + 7 - LO];
        const int row = R0 + half * 32 + tt;
        const int a = max(row - LO, S0), e = min(row + HI + 1, S1);
        db[(half * 32 + tt) * PL_DSTR + ch] = f2bf(s * __builtin_amdgcn_rcpf((float)(e - a)) - v[tt + 8]);
    }
}
__device__ __forceinline__ void pool_tiles(Frame& F, int l) {
    LAS float* us = (LAS float*)F.lds; LAS bf16_t* db = (LAS bf16_t*)(F.lds + 79 * 256 * 4);
    const int ch = F.tid & 255, half = F.tid >> 8, g = F.wave & 3, fr = F.lane & 15, fq = F.lane >> 4;
    bf16x8 wf[4][2];
    { const float* wp = F.in[I_WPOOL] + (size_t)(l * 4 + g) * 64 * 64;
#pragma unroll
      for (int nt = 0; nt < 4; ++nt)
#pragma unroll
        for (int kb = 0; kb < 2; ++kb) {
            u32x4 w;
            w.x = cvt_pk_bf16(wp[(32 * kb + 8 * fq + 0) * 64 + 16 * nt + fr], wp[(32 * kb + 8 * fq + 1) * 64 + 16 * nt + fr]);
            w.y = cvt_pk_bf16(wp[(32 * kb + 8 * fq + 2) * 64 + 16 * nt + fr], wp[(32 * kb + 8 * fq + 3) * 64 + 16 * nt + fr]);
            w.z = cvt_pk_bf16(wp[(32 * kb + 8 * fq + 4) * 64 + 16 * nt + fr], wp[(32 * kb + 8 * fq + 5) * 64 + 16 * nt + fr]);
            w.w = cvt_pk_bf16(wp[(32 * kb + 8 * fq + 6) * 64 + 16 * nt + fr], wp[(32 * kb + 8 * fq + 7) * 64 + 16 * nt + fr]);
            wf[nt][kb] = __builtin_bit_cast(bf16x8, w);
        } }
    f32x4 psc[4];
#pragma unroll
    for (int nt = 0; nt < 4; ++nt) psc[nt] = *(const f32x4*)(F.in[I_PSCALE] + l * 256 + g * 64 + 16 * nt + 4 * fq);
    u32x4 pv[5];
#define POOL_LOAD(tl) do { const int _R0 = (tl) * 64; const int _S0 = (_R0 < ML) ? (_R0 & ~(SEQ - 1)) : (ML + ((_R0 - ML) & ~(CTXL - 1))); const int _S1 = _S0 + ((_R0 < ML) ? SEQ : CTXL); \
        _Pragma("unroll") for (int it = 0; it < 5; ++it) { const int i = F.tid + it * NT, rr = i >> 5, c8 = (i & 31) * 8, row = _R0 - 8 + rr; pv[it] = (u32x4){0u, 0u, 0u, 0u}; \
            if (i < 79 * 32 && row >= _S0 && row < _S1) pv[it] = __builtin_nontemporal_load((const u32x4*)(F.P + (size_t)row * LDP + PPOOL + c8)); } } while (0)
    if (F.G - 1 - F.bid < M / 64) POOL_LOAD(F.G - 1 - F.bid);
    for (int tile = F.G - 1 - F.bid; tile < M / 64; tile += F.G) {
        const int R0 = tile * 64;
        const int S0 = (R0 < ML) ? (R0 & ~(SEQ - 1)) : (ML + ((R0 - ML) & ~(CTXL - 1)));
        const int S1 = S0 + ((R0 < ML) ? SEQ : CTXL);
        __syncthreads();
#pragma unroll
        for (int it = 0; it < 5; ++it) {
            const int i = F.tid + it * NT, rr = i >> 5, c8 = (i & 31) * 8;
            if (i < 79 * 32) {
                LAS f32x4* d = (LAS f32x4*)(us + rr * 256 + c8);
                d[0] = (f32x4){bflo(pv[it].x), bfhi(pv[it].x), bflo(pv[it].y), bfhi(pv[it].y)}; d[1] = (f32x4){bflo(pv[it].z), bfhi(pv[it].z), bflo(pv[it].w), bfhi(pv[it].w)};
            }
        }
        if (tile + F.G < M / 64) POOL_LOAD(tile + F.G);
        __syncthreads();
        if (g == 0) pool_diffs<0>(us, db, ch, half, R0, S0, S1);
        else if (g == 1) pool_diffs<1>(us, db, ch, half, R0, S0, S1);
        else if (g == 2) pool_diffs<2>(us, db, ch, half, R0, S0, S1);
        else pool_diffs<3>(us, db, ch, half, R0, S0, S1);
        __syncthreads();
#pragma unroll
        for (int mt = 0; mt < 2; ++mt) {
            bf16x8 df[2];
#pragma unroll
            for (int kb = 0; kb < 2; ++kb) df[kb] = *(const LAS bf16x8*)(db + (half * 32 + 16 * mt + fr) * PL_DSTR + g * 64 + 32 * kb + 8 * fq);
#pragma unroll
            for (int nt = 0; nt < 4; ++nt) {
                f32x4 acc = (f32x4){0.f, 0.f, 0.f, 0.f};
                acc = MFMA16(wf[nt][0], df[0], acc); acc = MFMA16(wf[nt][1], df[1], acc);
                acc *= psc[nt];
                u32x2 wv; wv.x = cvt_pk_bf16(acc[0], acc[1]); wv.y = cvt_pk_bf16(acc[2], acc[3]);
                *(u32x2*)(F.POOLO + (size_t)(R0 + half * 32 + 16 * mt + fr) * 256 + g * 64 + 16 * nt + 4 * fq) = wv;
            }
        }
    }
#undef POOL_LOAD
}

__device__ __forceinline__ void conv_tiles(Frame& F, int l) {
    LAS float* zs = (LAS float*)F.lds; LAS float* ys = (LAS float*)(F.lds + 62 * 256 * 4);
    const int ch = F.tid & 255, half = F.tid >> 8;
    float wk[31];
#pragma unroll
    for (int j = 0; j < 31; ++j) wk[j] = F.in[I_WDW][((size_t)l * 31 + j) * 256 + ch];
    const float bdw = F.in[I_BDW][l * 256 + ch];
    const f32x4 lg = *(const f32x4*)(F.in[I_LNG] + l * 256 + 4 * F.lane), lb = *(const f32x4*)(F.in[I_LNB] + l * 256 + 4 * F.lane);
    u32x4 av[4], gv[4];
#define CONV_LOAD(tl) do { const int _R0 = (tl) * 32; const int _S0 = (_R0 < ML) ? (_R0 & ~(SEQ - 1)) : (ML + ((_R0 - ML) & ~(CTXL - 1))); const int _S1 = _S0 + ((_R0 < ML) ? SEQ : CTXL); \
        _Pragma("unroll") for (int it = 0; it < 4; ++it) { const int i = F.tid + it * NT, rr = i >> 5, c8 = (i & 31) * 8, row = _R0 - 15 + rr; av[it] = (u32x4){0u, 0u, 0u, 0u}; gv[it] = (u32x4){0u, 0u, 0u, 0u}; \
            if (i < 62 * 32 && row >= _S0 && row < _S1) { av[it] = __builtin_nontemporal_load((const u32x4*)(F.P + (size_t)row * LDP + PCA + c8)); gv[it] = __builtin_nontemporal_load((const u32x4*)(F.P + (size_t)row * LDP + PCG + c8)); } } } while (0)
    const int vbc = ((F.G & 7) == 0) ? (F.bid & 7) * (F.G >> 3) + (F.bid >> 3) : F.bid;
    if (vbc < M / 32) CONV_LOAD(vbc);
    for (int tile = vbc; tile < M / 32; tile += F.G) {
        const int R0 = tile * 32;
        __syncthreads();
#pragma unroll
        for (int it = 0; it < 4; ++it) {
            const int i = F.tid + it * NT, rr = i >> 5, c8 = (i & 31) * 8;
            if (i < 62 * 32) {
                const u32x4 a = av[it], gq = gv[it];
                LAS f32x4* d = (LAS f32x4*)(zs + rr * 256 + c8);
                d[0] = (f32x4){bflo(a.x) * sigmoidf_(bflo(gq.x)), bfhi(a.x) * sigmoidf_(bfhi(gq.x)), bflo(a.y) * sigmoidf_(bflo(gq.y)), bfhi(a.y) * sigmoidf_(bfhi(gq.y))};
                d[1] = (f32x4){bflo(a.z) * sigmoidf_(bflo(gq.z)), bfhi(a.z) * sigmoidf_(bfhi(gq.z)), bflo(a.w) * sigmoidf_(bflo(gq.w)), bfhi(a.w) * sigmoidf_(bfhi(gq.w))};
            }
        }
        if (tile + F.G < M / 32) CONV_LOAD(tile + F.G);
        __syncthreads();
        {
            float acc[16];
#pragma unroll
            for (int t = 0; t < 16; ++t) acc[t] = bdw;
            float zv[46];
#pragma unroll
            for (int i = 0; i < 46; ++i) zv[i] = zs[(half * 16 + i) * 256 + ch];
#pragma unroll
            for (int i = 0; i < 46; ++i) {
#pragma unroll
                for (int t = 0; t < 16; ++t) { const int j = i - t; if (j >= 0 && j < 31) acc[t] += zv[i] * wk[j]; }
            }
#pragma unroll
            for (int t = 0; t < 16; ++t) ys[(half * 16 + t) * 256 + ch] = acc[t];
        }
        __syncthreads();
#pragma unroll
        for (int q = 0; q < 4; ++q) {
            const int t = F.wave * 4 + q;
            const f32x4 v = *(const LAS f32x4*)(ys + t * 256 + 4 * F.lane);
            const float mu = wave_sum((v.x + v.y) + (v.z + v.w)) * (1.0f / 256.0f);
            const f32x4 dv = v - mu;
            const float var = wave_sum((dv.x * dv.x + dv.y * dv.y) + (dv.z * dv.z + dv.w * dv.w)) * (1.0f / 256.0f);
            const float rstd = 1.0f / sqrtf(var + 1e-6f);
            f32x4 o = dv * rstd * lg + lb;
            o.x = o.x * sigmoidf_(o.x); o.y = o.y * sigmoidf_(o.y); o.z = o.z * sigmoidf_(o.z); o.w = o.w * sigmoidf_(o.w);
            u32x2 wv; wv.x = cvt_pk_bf16(o.x, o.y); wv.y = cvt_pk_bf16(o.z, o.w);
            *(u32x2*)(F.CONVO + (size_t)(R0 + t) * 256 + 4 * F.lane) = wv;
        }
    }
}

__device__ __forceinline__ void zero_fill(Frame& F, bf16_t* p, size_t nelem) { u32x4* q = (u32x4*)p; const size_t n = nelem / 8; for (size_t i = (size_t)F.bid * NT + F.tid; i < n; i += (size_t)F.G * NT) q[i] = (u32x4){0u, 0u, 0u, 0u}; }

#define XB_TMO      128
#define XB_XCNT(j)  (256  + 64 * (j))
#define XB_XSUB(j)  (1280 + 64 * (j))
#define XB_XGEN(j)  (2304 + 64 * (j))
#define XB_TOP      3328
#define XB_TOPGEN   3392
#define XCD_BAR_WORDS 3456
#define XB_SPIN_CAP (1u << 22)
__device__ __forceinline__ unsigned xb_ld(unsigned* p)              { return __hip_atomic_load(p, __ATOMIC_RELAXED, __HIP_MEMORY_SCOPE_AGENT); }
__device__ __forceinline__ unsigned xb_add(unsigned* p, unsigned v) { return __hip_atomic_fetch_add(p, v, __ATOMIC_RELAXED, __HIP_MEMORY_SCOPE_AGENT); }
__device__ __forceinline__ unsigned xb_xcc_id() { return (unsigned)__builtin_amdgcn_s_getreg((3 << 11) | 20) & 0xFu; }
#define XB_SPIN(cond, bar) do { unsigned _sp = 0; while (cond) { __builtin_amdgcn_s_sleep(1); \
    if ((++_sp & 255u) == 0u) { if (xb_ld(&(bar)[XB_TMO])) break; if (_sp > XB_SPIN_CAP) { atomicAdd(&(bar)[XB_TMO], 1u); break; } } } } while (0)
__device__ __forceinline__ void xcd_barrier_complete(unsigned* bar, unsigned x, unsigned& nloc, unsigned& nx) {
    const unsigned G = gridDim.x * gridDim.y * gridDim.z;
    unsigned sum, cnt, mine, sp = 0u;
    for (;;) {
        sum = 0u; cnt = 0u; mine = 0u;
#pragma unroll
        for (unsigned j = 0; j < 16; ++j) { const unsigned c = xb_ld(&bar[XB_XCNT(j)]); sum += c; cnt += (c > 0u) ? 1u : 0u; mine = (j == x) ? c : mine; }
        if (sum == G) break;
        __builtin_amdgcn_s_sleep(1);
        if ((++sp & 255u) == 0u) { if (xb_ld(&bar[XB_TMO])) break; if (sp > XB_SPIN_CAP) { atomicAdd(&bar[XB_TMO], 1u); break; } }
    }
    nloc = mine > 0u ? mine : 1u; nx = cnt > 0u ? cnt : 1u;
}
__device__ __forceinline__ void xcd_barrier(unsigned* bar, volatile LAS unsigned* st) {
    asm volatile("s_waitcnt vmcnt(0)" ::: "memory");
    __syncthreads();
    if (threadIdx.x == 0) {
        __builtin_amdgcn_s_waitcnt(0);
        const unsigned x = xb_xcc_id();
        unsigned nloc = st[0], nx = st[1];
        if (nloc == 0u) { xcd_barrier_complete(bar, x, nloc, nx); st[0] = nloc; st[1] = nx; }
        const unsigned old = xb_add(&bar[XB_XSUB(x)], 1u);
        const unsigned gen = old / nloc;
        if (old + 1u == (gen + 1u) * nloc) {
            __builtin_amdgcn_fence(__ATOMIC_RELEASE, "agent");
            asm volatile("s_waitcnt vmcnt(0)" ::: "memory");
            const unsigned og = xb_add(&bar[XB_TOP], 1u);
            const unsigned tg = og / nx;
            if (og + 1u == (tg + 1u) * nx) xb_add(&bar[XB_TOPGEN], 1u);
            else XB_SPIN(xb_ld(&bar[XB_TOPGEN]) == tg, bar);
            __builtin_amdgcn_fence(__ATOMIC_ACQUIRE, "agent");
            xb_add(&bar[XB_XGEN(x)], 1u);
            asm volatile("s_waitcnt vmcnt(0)" ::: "memory");
        } else {
            XB_SPIN(xb_ld(&bar[XB_XGEN(x)]) == gen, bar);
            __builtin_amdgcn_fence(__ATOMIC_ACQUIRE, "agent");
            asm volatile("s_waitcnt vmcnt(0)" ::: "memory");
        }
    }
    __syncthreads();
}
constexpr size_t WS_BAR = 2 * MiB + 768 * 1024;
constexpr int LDS_BARST = LDS_BYTES - 64;
__device__ __forceinline__ void build_frame(Frame& F, unsigned char* lds_raw) {
    int t = threadIdx.x; asm volatile("" : "+v"(t));
    unsigned long long ka = (unsigned long long)__builtin_amdgcn_kernarg_segment_ptr(); asm volatile("" : "+s"(ka));
    F.lds = (LAS unsigned char*)lds_raw;
    F.tid = t; F.lane = t & 63; F.wave = __builtin_amdgcn_readfirstlane(t >> 6); F.G = gridDim.x; F.bid = blockIdx.x;
    F.in = (const KAS cfp*)ka; F.out = *(float* const KAS*)(ka + 192); unsigned char* ws = *(unsigned char* const KAS*)(ka + 200); F.ws = ws;
    F.MOD = (float*)(ws + WS_MOD); F.ROPE = (const f32x2*)(ws + WS_ROPE); F.TW = (const f32x2*)(ws + WS_TW); F.DFT = (const bf16_t*)(ws + WS_DFT); F.XC = (float*)(ws + WS_XC);
    F.WT = (bf16_t*)(ws + WS_WT); F.H = (bf16_t*)F.out; F.XB = (bf16_t*)(ws + WS_XB);
    F.P = (bf16_t*)(ws + WS_R1 + R1_P); F.VT = (bf16_t*)(ws + WS_R1 + R1_VT); F.ZA = (bf16_t*)(ws + WS_R1 + R1_ZA); F.ZC = (bf16_t*)(ws + WS_R1 + R1_ZC); F.TP = (bf16_t*)(ws + WS_R1 + R1_TP);
    F.Y = (bf16_t*)(ws + WS_R1); F.U = (bf16_t*)(ws + WS_R1);
    F.ATTN = (bf16_t*)(ws + WS_R2 + R2_ATTN); F.POOLO = (bf16_t*)(ws + WS_R2 + R2_POOL); F.FOURO = (bf16_t*)(ws + WS_R2 + R2_FOUR); F.CONVO = (bf16_t*)(ws + WS_R2 + R2_CONV);
    F.MERGED = (bf16_t*)(ws + WS_R1 + R1_MG);
}
static_assert(sizeof(Args) == 216 && offsetof(Args, out) == 192 && offsetof(Args, ws) == 200, "kernarg layout");
constexpr int PH_PER_LAYER = 10, NPH = 1 + NL * PH_PER_LAYER + 1;
__global__ void __launch_bounds__(NT, 2) fwd_kernel(Args args) {
    extern __shared__ __attribute__((aligned(16))) unsigned char lds_raw[];
    const int lo = args.ph_lo, hi = args.ph_hi;
#define IN(k) (lo <= (k) && (k) < hi)
#define INP(j) (IN(p0 + (j)) && PHON(j))
#define XL_IN ((l == 0) ? F.in[I_X] : (const float*)nullptr)
#define XC_IN ((l == 0) ? F.in[I_CTX] : F.XC)
#define PB6 ((float*)(F.ws + WS_R2))
#define PB9 ((float*)(F.ws + WS_R2))
#define Hc ((const char*)F.H)
#define WTc ((const char*)F.WT)
#define SEAM(k) do { if (IN(k) && IN((k) + 1)) { xcd_barrier(xbar, xst); } } while (0)
    unsigned* xbar = (unsigned*)(args.ws + WS_BAR); volatile LAS unsigned* xst = (volatile LAS unsigned*)((LAS unsigned char*)lds_raw + LDS_BARST);
    if (threadIdx.x == 0) { xst[0] = 0u; xst[1] = 0u; }
    if (lo == 0 && hi > 1) {
        if (blockIdx.x == 0) for (int i = threadIdx.x; i < XCD_BAR_WORDS; i += NT) __hip_atomic_store(xbar + i, 0u, __ATOMIC_RELAXED, __HIP_MEMORY_SCOPE_AGENT);
        cg::this_grid().sync();
        if (threadIdx.x == 0) (void)xb_add(&xbar[XB_XCNT(xb_xcc_id())], 1u);
    }
    __syncthreads();
    if (IN(0) && PHON(10)) { Frame F; build_frame(F, lds_raw); p0_prologue(F);
#ifdef SCRUB
        { u32x4* p = (u32x4*)(F.ws + WS_XB); const size_t n = (WS_END - WS_XB) / 16; for (size_t i = (size_t)F.bid * NT + F.tid; i < n; i += (size_t)F.G * NT) p[i] = (u32x4){0xAAAAAAAAu, 0xAAAAAAAAu, 0xAAAAAAAAu, 0xAAAAAAAAu}; }
#endif
    }
    SEAM(0);
    for (int l = 0; l < NL; ++l) {
        const int p0 = 1 + l * PH_PER_LAYER;
        const bool lastl = (l == NL - 1);
        const int nMr = lastl ? 128 : 132;
        if (INP(0)) for (int rep = 0; rep < NREP(0); ++rep) { Frame F; build_frame(F, lds_raw); norm_mod_rows(F, l, XL_IN, XC_IN, F.XC, PB9, (l == 0 || rep > 0) ? 0 : 16, (l == 0) ? nullptr : mod_ptr(F, l - 1, 4, 5), F.in[I_GMIX] + l * D, 0, 1, M); __syncthreads(); convert_weights(F, l); }
        SEAM(p0 + 0);
        if (INP(1)) for (int rep = 0; rep < NREP(1); ++rep) { Frame F; build_frame(F, lds_raw);
            __syncthreads();
            { Order1 S{F.G, F.bid, Hc, WTc, lastl ? 0 : 64}; Epi1 E{F.P, F.VT, F.ZC, F.ROPE, (bf16_t*)(F.ws + WS_R1 + R1_GC)}; pg8::gemm_phase(F.lds, F.tid, S, E); }
            { Order2 S{F.G, F.bid, Hc, WTc}; EpiPlain E{F.ZA, 512, (size_t)512 * 512, 0}; pg8::gemm_phase(F.lds, F.tid, S, E); }
        }
        SEAM(p0 + 1);
        if (INP(2)) for (int rep = 0; rep < NREP(2); ++rep) { Frame F; build_frame(F, lds_raw);
            const int nunits = 1024 + (lastl ? 0 : 32);
#if !(EXPM & 1)
            const int vb = ((F.G & 7) == 0) ? (F.bid & 7) * (F.G >> 3) + (F.bid >> 3) : F.bid;
            for (int u = vb; u < nunits; u += F.G) {
                if (u < 1024) { const int rb = u & 31, h = (u >> 5) & 7, b = u >> 8; attn_unit(F, l, b, h, rb); }
                else { const int v = u - 1024; attn_unit(F, l, v >> 3, v & 7, -1); }
            }
#endif
#if !(EXPM & 2)
            four_stageA(F); if (REP2 & 8) four_stageA(F);
#endif
            if (EXPM & 1) zero_fill(F, F.ATTN, (size_t)M * 512);
        }
        SEAM(p0 + 2);
        if (INP(3)) for (int rep = 0; rep < NREP(3); ++rep) { Frame F; build_frame(F, lds_raw); __syncthreads();
            if (EXPM & 4) zero_fill(F, F.POOLO, (size_t)M * 256); else { pool_tiles(F, l); if (REP2 & 1) { __syncthreads(); pool_tiles(F, l); } }
            __syncthreads();
            if (EXPM & 8) zero_fill(F, F.CONVO, (size_t)M * 256); else { conv_tiles(F, l); if (REP2 & 2) { __syncthreads(); conv_tiles(F, l); } }
            if (EXPM & 2) zero_fill(F, F.FOURO, (size_t)M * 256); else four_stageB(F); }
        SEAM(p0 + 3);
        if (INP(5)) for (int rep = 0; rep < NREP(5); ++rep) { Frame F; build_frame(F, lds_raw); __syncthreads();
            OrderF S{F.G, F.bid, lastl ? 0 : 64, Hc, WTc, (const char*)(F.ws + WS_R2)};
            EpiFused E{F.MERGED, (bf16_t*)(F.ws + WS_R1 + R1_GYC), F.ws + WS_R1 + R1_YSCR + (size_t)F.bid * 131072, (const bf16_t*)(F.ws + WS_R1 + R1_GC)};
            pg8::gemm_phase(F.lds, F.tid, S, E); }
        SEAM(p0 + 5);
        if (INP(6)) for (int rep = 0; rep < NREP(6); ++rep) { Frame F; build_frame(F, lds_raw); __syncthreads();
            { OrderN S{F.G, F.bid, 128, 4, 1, 1024, 1024, (const char*)F.MERGED, WTc + WT_O * 2, 0, 0}; EpiRes E{F.XB, F.MOD + (size_t)l * 5 * 6144, 2}; pg8::gemm_phase(F.lds, F.tid, S, E); }
            if (!lastl) { OrderMini S{F.G, F.bid, 16, 256, 4096, 1024, 1024, (const char*)(F.ws + WS_R1 + R1_GYC), WTc + WT_O * 2}; EpiPartial E{PB6}; pg8::gemm_phase(F.lds, F.tid, S, E); }
        }
        SEAM(p0 + 6);
        if (INP(7)) for (int rep = 0; rep < NREP(7); ++rep) { Frame F; build_frame(F, lds_raw); norm_mod_rows(F, l, nullptr, F.XC, F.XC, PB6, (rep > 0) ? 0 : 16, mod_ptr(F, l, 4, 2), F.in[I_GFF] + l * D, 3, 4, lastl ? ML : M); }
        SEAM(p0 + 7);
        if (INP(8)) for (int rep = 0; rep < NREP(8); ++rep) { Frame F; build_frame(F, lds_raw); __syncthreads(); OrderN S{F.G, F.bid, nMr, 16, 1, 1024, 1024, Hc, WTc + WT_1 * 2, 0, 0}; EpiPlain E{F.U, 4096, 0, 1}; pg8::gemm_phase(F.lds, F.tid, S, E); }
        SEAM(p0 + 8);
        if (INP(9)) for (int rep = 0; rep < NREP(9); ++rep) { Frame F; build_frame(F, lds_raw); __syncthreads();
            { OrderN S{F.G, F.bid, 128, 4, 1, 4096, 4096, (const char*)F.U, WTc + WT_2 * 2, 0, 0}; EpiRes E{F.XB, F.MOD + (size_t)l * 5 * 6144, 5}; pg8::gemm_phase(F.lds, F.tid, S, E); }
            if (!lastl) { OrderMini S{F.G, F.bid, 16, 256, 4096, 4096, 4096, (const char*)(F.U + (size_t)ML * 4096), WTc + WT_2 * 2}; EpiPartial E{PB9}; pg8::gemm_phase(F.lds, F.tid, S, E); }
        }
        SEAM(p0 + 9);
    }
    if (IN(NPH - 1) && PHON(11)) { Frame F; build_frame(F, lds_raw); final_norm(F); }
#undef IN
#undef SEAM
}

extern "C" void kernel_launch(void* const* d_in, const int* in_sizes, int n_in, void* d_out, int out_size, void* d_ws, size_t ws_size, hipStream_t stream) {
    static int grid = 0;
    if (grid == 0) {
        if (n_in != 24 || out_size != ML * D || ws_size < WS_END) { fprintf(stderr, "kernel_launch: unexpected shapes (n_in %d out %d ws %zu)\n", n_in, out_size, ws_size); grid = -1; return; }
        int dev = 0, cus = 0, per_cu = 0;
        hipGetDevice(&dev); hipDeviceGetAttribute(&cus, hipDeviceAttributeMultiprocessorCount, dev);
        if (hipFuncSetAttribute((const void*)fwd_kernel, hipFuncAttributeMaxDynamicSharedMemorySize, LDS_BYTES) != hipSuccess) { fprintf(stderr, "kernel_launch: hipFuncSetAttribute failed\n"); grid = -1; return; }
        if (hipOccupancyMaxActiveBlocksPerMultiprocessor(&per_cu, (const void*)fwd_kernel, NT, LDS_BYTES) != hipSuccess || per_cu < 1) { fprintf(stderr, "kernel_launch: occupancy query says %d\n", per_cu); per_cu = 1; }
        (void)hipGetLastError();
        grid = cus * 1;
    }
    if (grid < 0) return;
    Args a{};
    for (int i = 0; i < 24; ++i) a.in[i] = (const float*)d_in[i];
    a.out = (float*)d_out; a.ws = (unsigned char*)d_ws;
#if MK_ONE_LAUNCH
    a.ph_lo = 0; a.ph_hi = NPH;
    void* kargs[] = {&a};
    hipError_t e = hipLaunchCooperativeKernel((const void*)fwd_kernel, dim3(grid), dim3(NT), kargs, LDS_BYTES, stream);
    if (e != hipSuccess) fprintf(stderr, "cooperative launch failed: %s (grid %d)\n", hipGetErrorString(e), grid);
#else
    for (int p = 0; p < NPH; ++p) { a.ph_lo = p; a.ph_hi = p + 1; hipLaunchKernelGGL(fwd_kernel, dim3(grid), dim3(NT), LDS_BYTES, stream, a); }
#endif
}
```

```cpp
#include <hip/hip_runtime.h>
#include <hip/hip_cooperative_groups.h>
#include <cstdio>
#include <cstdint>
namespace cg = cooperative_groups;

#define LAS __attribute__((address_space(3)))
typedef unsigned short bf16_t;
typedef short bf16x8 __attribute__((ext_vector_type(8)));
typedef short s16x4 __attribute__((ext_vector_type(4)));
typedef float f32x4 __attribute__((ext_vector_type(4)));
typedef float f32x2 __attribute__((ext_vector_type(2)));
typedef unsigned u32x4 __attribute__((ext_vector_type(4)));
typedef unsigned u32x2 __attribute__((ext_vector_type(2)));

#ifndef PHMASK
#define PHMASK 0xFFFF
#endif
#define PHON(j) (((PHMASK) >> (j)) & 1)
#ifndef REP2
#define REP2 0
#endif
#ifndef REPMASK
#define REPMASK 0
#endif
#define NREP(j) (1 + (((REPMASK) >> (j)) & 1))
#ifndef EXPM2
#define EXPM2 0
#endif
#ifndef EXPM
#define EXPM 0
#endif
#ifndef MK_ONE_LAUNCH
#define MK_ONE_LAUNCH 1
#endif

constexpr int D = 1024, NBATCH = 4, SEQ = 8192, NL = 4, CTXL = 256, DFF = 4096;
constexpr int ML = NBATCH * SEQ;
constexpr int MC = NBATCH * CTXL;
constexpr int M = ML + MC;
constexpr int INW = 6656;
constexpr int W_Q = 0, W_K = 512, W_V = 1024, W_POOL = 1536, W_FOUR = 1792, W_CONV = 2048, W_GATE = 2560;
constexpr int LDP = 1792;
constexpr int PQ = 0, PK = 512, PPOOL = 1024, PCA = 1280, PCG = 1536;
constexpr int NWAVES = 8, NT = 512;
constexpr int LDS_BYTES = 147456;

constexpr size_t MiB = 1u << 20;
constexpr size_t WS_MOD = 0;
constexpr size_t WS_ROPE = 1 * MiB;
constexpr size_t WS_TW = 1 * MiB + 65536;
constexpr size_t WS_DFT = 2 * MiB;
constexpr size_t DFT_C128 = 0, DFT_S128 = 32768, DFT_C64 = 65536, DFT_S64 = 65536 + 8192, DFT_C256 = 65536 + 16384, DFT_S256 = 65536 + 16384 + 131072;
constexpr size_t WS_XC = 3 * MiB;
constexpr size_t WS_WT = 7 * MiB;
constexpr size_t WT_NAT = 0, WT_V = WT_NAT + 1792 * 1024, WT_F = WT_V + 512 * 1024, WT_G = WT_F + 512 * 1024, WT_BA = WT_G + 4096 * 1024,
                 WT_BP = WT_BA + 1024 * 512, WT_BF = WT_BP + 1024 * 256, WT_BC = WT_BF + 1024 * 256, WT_O = WT_BC + 1024 * 256,
                 WT_1 = WT_O + 1024 * 1024, WT_2 = WT_1 + 4096 * 1024, WT_END = WT_2 + 4096 * 1024;
static_assert(WT_END * 2 == 34 * MiB, "weight map");
constexpr size_t WS_XB = 41 * MiB;
constexpr size_t WS_R1 = 107 * MiB;
constexpr size_t R1_MG = 0, R1_GYC = 66 * MiB, R1_YSCR = 80 * MiB, R1_GC = 216 * MiB;
constexpr size_t R1_P = 0, R1_VT = 116 * MiB, R1_ZA = 149 * MiB, R1_ZC = 181 * MiB, R1_TP = 182 * MiB;
constexpr size_t WS_R2 = 371 * MiB;
constexpr size_t R2_ATTN = 0, R2_POOL = 33 * MiB, R2_FOUR = R2_POOL + (size_t)M * 256 * 2, R2_CONV = R2_FOUR + (size_t)M * 256 * 2;
constexpr size_t OUT_PB6 = 66 * MiB;
constexpr size_t WS_END = 455 * MiB;
static_assert(R2_CONV + (size_t)M * 256 * 2 <= 84 * MiB && (size_t)M * LDP * 2 <= 116 * MiB, "ws map");

typedef __bf16 bf16x2_t __attribute__((ext_vector_type(2)));
__device__ __forceinline__ unsigned cvt_pk_bf16(float lo, float hi) { const f32x2 v = {lo, hi}; const bf16x2_t b = __builtin_convertvector(v, bf16x2_t); return __builtin_bit_cast(unsigned, b); }
__device__ __forceinline__ bf16_t f2bf(float f) { unsigned u = __builtin_bit_cast(unsigned, f); return (bf16_t)((u + 0x7fffu + ((u >> 16) & 1u)) >> 16); }
__device__ __forceinline__ float bf2f(bf16_t b) { return __builtin_bit_cast(float, (unsigned)b << 16); }
__device__ __forceinline__ float bflo(unsigned w) { return __builtin_bit_cast(float, w << 16); }
__device__ __forceinline__ float bfhi(unsigned w) { return __builtin_bit_cast(float, w & 0xffff0000u); }
__device__ __forceinline__ float wave_sum(float v) {
#pragma unroll
    for (int o = 1; o < 64; o <<= 1) v += __shfl_xor(v, o);
    return v;
}
__device__ __forceinline__ float sigmoidf_(float x) { return __builtin_amdgcn_rcpf(1.0f + __builtin_amdgcn_exp2f(-1.4426950408889634f * x)); }
#define MFMA16(a, b, c) __builtin_amdgcn_mfma_f32_16x16x32_bf16((a), (b), (c), 0, 0, 0)

namespace pg8 {
constexpr int BM = 256, BK = 64, HALF = 128, HTB = HALF * BK * 2, STAGE_BYTES = 8 * HTB, NXCD = 8, WGM = 8;
__host__ __device__ __forceinline__ int lds_byte(int r, int c) { const int st = (r >> 4) * 2 + (c >> 5), rr = r & 15, cc = c & 31, ob = rr * 64 + cc * 2; return st * 1024 + (ob ^ (((ob >> 9) & 1) << 5)); }
__host__ __device__ __forceinline__ void stage_rc(int b, int& R, int& C) { const int st = b / 1024, sb = b % 1024, swz = sb ^ (((sb >> 9) & 1) << 5); R = (st >> 1) * 16 + swz / 64; C = (st & 1) * 32 + (swz % 64) / 2; }
__host__ __device__ __forceinline__ int perm32(int rho) { const int n = rho >> 4, i = rho & 15; return 8 * (i >> 2) + 4 * n + (i & 3); }

struct Unit { const char* a; const char* b; int pm, pn, kind, lda, ldb, nt; };

__device__ __forceinline__ void tile_map(int L, int nM, int nN, int& pm, int& pn) {
    const int nwg = nM * nN; int wgid = L;
    { const int q = nwg / NXCD, r = nwg % NXCD, xcd = wgid % NXCD, off = wgid / NXCD; wgid = (xcd < r ? xcd * (q + 1) : r * (q + 1) + (xcd - r) * q) + off; }
    const int nig = WGM * nN, gid = wgid / nig, fm = gid * WGM, gsz = (nM - fm) < WGM ? (nM - fm) : WGM;
    pm = fm + ((wgid % nig) % gsz); pn = (wgid % nig) / gsz;
}

template <class Epi, class Sched>
__device__ __forceinline__ void gemm_phase(LAS unsigned char* lds, const int tid, const Sched& S, const Epi& E) {
    const int wid = __builtin_amdgcn_readfirstlane(tid >> 6), lane = tid & 63, wr = wid >> 2, wc = wid & 3, fr = lane & 15, fq = lane >> 4;
    int R0, C0; stage_rc(tid * 16, R0, C0); const int Rb0 = Epi::PERM ? ((R0 & ~31) + perm32(R0 & 31)) : R0;
    const size_t kstep = (size_t)(BK * 2);
    const unsigned ldsw = (unsigned)wid * 1024u;
    const int aoff = lds_byte(wr * 64 + fr, fq * 8), boff = lds_byte(wc * 32 + fr, fq * 8);
#define PG8_SA(b, h) (((b) * 2 + (h)) * HTB)
#define PG8_SB(b, h) ((4 + (b) * 2 + (h)) * HTB)
#define PG8_STAGE(bufoff, gbase, voff, hstep) do { _Pragma("unroll") for (int _i = 0; _i < 2; ++_i) \
        __builtin_amdgcn_global_load_lds((const unsigned*)((const char*)(gbase) + (size_t)_i * ((hstep) >> 1) + (voff)), (LAS unsigned*)(lds + (bufoff) + ldsw + _i * 8192), 16, 0, 0); } while (0)
#define PG8_LDA(dst, b, h) do { _Pragma("unroll") for (int m = 0; m < 4; ++m) _Pragma("unroll") for (int k = 0; k < 2; ++k) dst[m][k] = *(const LAS bf16x8*)(lds + PG8_SA(b, h) + aoff + m * 2048 + k * 1024); } while (0)
#define PG8_LDB(dst, b, h) do { _Pragma("unroll") for (int n = 0; n < 2; ++n) _Pragma("unroll") for (int k = 0; k < 2; ++k) dst[n][k] = *(const LAS bf16x8*)(lds + PG8_SB(b, h) + boff + n * 2048 + k * 1024); } while (0)
#define PG8_MMA(ai, bj, At, Bt) do { __builtin_amdgcn_s_setprio(1); _Pragma("unroll") for (int m = 0; m < 4; ++m) _Pragma("unroll") for (int n = 0; n < 2; ++n) _Pragma("unroll") for (int k = 0; k < 2; ++k) \
        acc[ai][bj][m][n] = __builtin_amdgcn_mfma_f32_16x16x32_bf16(Bt[n][k], At[m][k], acc[ai][bj][m][n], 0, 0, 0); __builtin_amdgcn_s_setprio(0); } while (0)
#define PG8_WAIT_V(n) asm volatile("s_waitcnt vmcnt(" #n ")" ::: "memory")
#define PG8_WAIT_L(n) asm volatile("s_waitcnt lgkmcnt(" #n ")" ::: "memory")
#define PG8_BAR __builtin_amdgcn_s_barrier()
#define PG8_SCHED __builtin_amdgcn_sched_barrier(0)
    Unit cur, nxt; int ui = 0;
    if (!S.next(0, cur)) return;
    f32x4 acc[2][2][4][2];
#pragma unroll
    for (int a = 0; a < 2; ++a)
#pragma unroll
        for (int b = 0; b < 2; ++b)
#pragma unroll
            for (int m = 0; m < 4; ++m)
#pragma unroll
                for (int n = 0; n < 2; ++n) acc[a][b][m][n] = (f32x4){0.f, 0.f, 0.f, 0.f};
    bf16x8 At[4][2], B0[2][2], B1[2][2];
    const char* cA = cur.a; const char* cB = cur.b;
    unsigned vAc = (unsigned)(R0 * cur.lda + C0) * 2u, vBc = (unsigned)(Rb0 * cur.ldb + C0) * 2u;
    size_t hAc = (size_t)HALF * cur.lda * 2, hBc = (size_t)HALF * cur.ldb * 2;
    PG8_STAGE(PG8_SB(0, 0), cB, vBc, hBc); PG8_STAGE(PG8_SA(0, 0), cA, vAc, hAc); PG8_STAGE(PG8_SB(0, 1), cB + hBc, vBc, hBc); PG8_STAGE(PG8_SA(0, 1), cA + hAc, vAc, hAc);
    if (wr == 1) PG8_BAR;
    PG8_WAIT_V(4); PG8_BAR;
    PG8_STAGE(PG8_SB(1, 0), cB + kstep, vBc, hBc); PG8_STAGE(PG8_SA(1, 0), cA + kstep, vAc, hAc); PG8_STAGE(PG8_SB(1, 1), cB + hBc + kstep, vBc, hBc);
    PG8_WAIT_V(6); PG8_BAR;
    for (;;) {
        const bool has_next = S.next(ui + 1, nxt);
        const char* nA = has_next ? nxt.a : cA; const char* nB = has_next ? nxt.b : cB;
        const unsigned vAn = has_next ? (unsigned)(R0 * nxt.lda + C0) * 2u : vAc, vBn = has_next ? (unsigned)(Rb0 * nxt.ldb + C0) * 2u : vBc;
        const size_t hAn = has_next ? (size_t)HALF * nxt.lda * 2 : hAc, hBn = has_next ? (size_t)HALF * nxt.ldb * 2 : hBc;
        const int nt = cur.nt;
        for (int t = 0; t < nt; t += 2) {
            const bool last = (t == nt - 2);
            const char* a1 = cA + (size_t)(t + 1) * kstep;
            const char* a2 = last ? nA : cA + (size_t)(t + 2) * kstep; const char* b2 = last ? nB : cB + (size_t)(t + 2) * kstep;
            const char* a3 = a2 + kstep; const char* b3 = b2 + kstep;
            const unsigned vA2 = last ? vAn : vAc, vB2 = last ? vBn : vBc;
            const size_t hA2 = last ? hAn : hAc, hB2 = last ? hBn : hBc;
            PG8_LDB(B0, 0, 0); PG8_SCHED; PG8_LDA(At, 0, 0); PG8_STAGE(PG8_SA(1, 1), a1 + hAc, vAc, hAc);
            PG8_WAIT_L(8); PG8_BAR; PG8_WAIT_L(0); PG8_MMA(0, 0, At, B0); PG8_BAR; PG8_SCHED;
            PG8_LDB(B1, 0, 1); PG8_STAGE(PG8_SB(0, 0), b2, vB2, hB2);
            PG8_BAR; PG8_WAIT_L(0); PG8_MMA(0, 1, At, B1); PG8_BAR;
            PG8_LDA(At, 0, 1); PG8_STAGE(PG8_SA(0, 0), a2, vA2, hA2);
            PG8_BAR; PG8_WAIT_L(0); PG8_MMA(1, 0, At, B0); PG8_BAR; PG8_SCHED;
            PG8_STAGE(PG8_SB(0, 1), b2 + hB2, vB2, hB2);
            PG8_WAIT_V(6); PG8_BAR; PG8_MMA(1, 1, At, B1); PG8_BAR;
            PG8_LDB(B0, 1, 0); PG8_SCHED; PG8_LDA(At, 1, 0); PG8_STAGE(PG8_SA(0, 1), a2 + hA2, vA2, hA2);
            PG8_WAIT_L(8); PG8_BAR; PG8_WAIT_L(0); PG8_MMA(0, 0, At, B0); PG8_BAR; PG8_SCHED;
            PG8_LDB(B1, 1, 1); PG8_STAGE(PG8_SB(1, 0), b3, vB2, hB2);
            PG8_BAR; PG8_WAIT_L(0); PG8_MMA(0, 1, At, B1); PG8_BAR;
            PG8_LDA(At, 1, 1); PG8_STAGE(PG8_SA(1, 0), a3, vA2, hA2);
            PG8_BAR; PG8_WAIT_L(0); PG8_MMA(1, 0, At, B0); PG8_BAR; PG8_SCHED;
            PG8_STAGE(PG8_SB(1, 1), b3 + hB2, vB2, hB2);
            PG8_WAIT_V(6); PG8_BAR; PG8_MMA(1, 1, At, B1); PG8_BAR;
        }
        E(acc, cur, wr, wc, fr, fq);
        if (!has_next) break;
#pragma unroll
        for (int a = 0; a < 2; ++a)
#pragma unroll
            for (int b = 0; b < 2; ++b)
#pragma unroll
                for (int m = 0; m < 4; ++m)
#pragma unroll
                    for (int n = 0; n < 2; ++n) acc[a][b][m][n] = (f32x4){0.f, 0.f, 0.f, 0.f};
        cur = nxt; cA = nA; cB = nB; vAc = vAn; vBc = vBn; hAc = hAn; hBc = hBn; ++ui;
    }
    PG8_WAIT_V(0);
    if (wr == 0) PG8_BAR;
    PG8_BAR;
#undef PG8_SA
#undef PG8_SB
#undef PG8_STAGE
#undef PG8_LDA
#undef PG8_LDB
#undef PG8_MMA
#undef PG8_WAIT_V
#undef PG8_WAIT_L
#undef PG8_BAR
#undef PG8_SCHED
}
}
using pg8::Unit;

struct Args {
    const float* in[24];
    float* out; unsigned char* ws;
    int ph_lo, ph_hi;
};
enum { I_X = 0, I_C, I_CTX, I_CCTX, I_WMOD, I_BMOD, I_GMIX, I_GFF, I_WIN, I_RPB, I_WPOOL, I_PSCALE, I_WDW, I_BDW, I_LNG, I_LNB, I_WBA, I_WBP, I_WBF, I_WBC, I_WOUT, I_WFF1, I_WFF2, I_GFINAL };

#define KAS __attribute__((address_space(4)))
typedef const float* cfp;
struct Frame {
    LAS unsigned char* lds;
    int tid, lane, wave, G, bid;
    const KAS cfp* in;
    float* out; unsigned char* ws;
    float* MOD; const f32x2* ROPE; const f32x2* TW; const bf16_t* DFT; float* XC;
    bf16_t* WT; bf16_t* H; bf16_t* XB; bf16_t* P; bf16_t* VT; bf16_t* ZA; bf16_t* ZC; bf16_t* TP; bf16_t* Y; bf16_t* U;
    bf16_t* ATTN; bf16_t* POOLO; bf16_t* FOURO; bf16_t* CONVO; bf16_t* MERGED;
};
__device__ __forceinline__ const float* mod_ptr(const Frame& F, int l, int mi, int chunk) { return F.MOD + ((size_t)(l * 5 + mi) * 6 + chunk) * D; }
__device__ __forceinline__ int row_mi(int row) { return row < ML ? (row >> 13) : 4; }
__device__ __forceinline__ int tile_mi(int pm) { return pm < 128 ? (pm >> 5) : 4; }

__device__ __forceinline__ void p0_prologue(Frame& F) {
    LAS float* sv = (LAS float*)F.lds;
    LAS float* red = (LAS float*)(F.lds + 5 * 1024 * 4);
    const float* c = F.in[I_C]; const float* cc = F.in[I_CCTX];
    for (int i = F.tid; i < 5 * D; i += NT) { const float v = (i < 4 * D) ? c[i] : cc[i - 4 * D]; sv[i] = v / (1.0f + __expf(-v)); }
    __syncthreads();
    for (int it = F.bid; it < NL * 48; it += F.G) {
        const int l = it / 48, n0 = (it % 48) * 128;
        const float* w = F.in[I_WMOD] + (size_t)l * D * 6144 + n0 + 2 * F.lane;
        float a[5][2];
#pragma unroll
        for (int j = 0; j < 5; ++j) { a[j][0] = 0.f; a[j][1] = 0.f; }
        const int k0 = F.wave * 128;
#pragma unroll 4
        for (int k = k0; k < k0 + 128; ++k) {
            const f32x2 wv = *(const f32x2*)(w + (size_t)k * 6144);
#pragma unroll
            for (int j = 0; j < 5; ++j) { const float s = sv[j * D + k]; a[j][0] += s * wv.x; a[j][1] += s * wv.y; }
        }
#pragma unroll
        for (int j = 0; j < 5; ++j) { red[(F.wave * 5 + j) * 128 + 2 * F.lane] = a[j][0]; red[(F.wave * 5 + j) * 128 + 2 * F.lane + 1] = a[j][1]; }
        __syncthreads();
        for (int o = F.tid; o < 5 * 128; o += NT) {
            const int j = o >> 7, n = o & 127; float s = 0.f;
#pragma unroll
            for (int wv = 0; wv < 8; ++wv) s += red[(wv * 5 + j) * 128 + n];
            F.MOD[(size_t)(l * 5 + j) * 6144 + n0 + n] = s + F.in[I_BMOD][l * 6144 + n0 + n];
        }
        __syncthreads();
    }
    const int gt = F.bid * NT + F.tid, GT = F.G * NT;
    f32x2* rope = (f32x2*)(F.ws + WS_ROPE);
    for (int i = gt; i < 128 * 16; i += GT) { const int pos = i >> 4, f = i & 15; const float inv = powf(10000.0f, -(float)(2 * f) / 32.0f); const float ang = (float)pos * inv; rope[i] = (f32x2){cosf(ang), sinf(ang)}; }
    f32x2* tw = (f32x2*)(F.ws + WS_TW);
    for (int i = gt; i < 8192; i += GT) { const float ang = 6.283185307179586f * (float)i / 8192.0f; tw[i] = (f32x2){cosf(ang), sinf(ang)}; }
    bf16_t* dft = (bf16_t*)(F.ws + WS_DFT);
    for (int i = gt; i < 128 * 128; i += GT) { const int k = i >> 7, n = i & 127; const float ang = 6.283185307179586f * (float)((k * n) & 127) / 128.0f; dft[DFT_C128 / 2 + i] = f2bf(cosf(ang)); dft[DFT_S128 / 2 + i] = f2bf(sinf(ang)); }
    for (int i = gt; i < 64 * 64; i += GT) { const int k = i >> 6, n = i & 63; const float ang = 6.283185307179586f * (float)((k * n) & 63) / 64.0f; dft[DFT_C64 / 2 + i] = f2bf(cosf(ang)); dft[DFT_S64 / 2 + i] = f2bf(sinf(ang)); }
    for (int i = gt; i < 256 * 256; i += GT) { const int k = i >> 8, n = i & 255; const float ang = 6.283185307179586f * (float)((k * n) & 255) / 256.0f; dft[DFT_C256 / 2 + i] = f2bf(cosf(ang)); dft[DFT_S256 / 2 + i] = f2bf(sinf(ang)); }
}

__device__ __forceinline__ void tr_item(const float* W, int ldw, int col0, int nblk, bf16_t* WT, int K, int drow0, LAS float* scr, int item, int lane) {
    const int kb = item / nblk, nb = item % nblk, k0 = 64 * kb, n0 = 32 * nb;
#pragma unroll 8
    for (int i = 0; i < 32; ++i) { const int kk = 2 * i + (lane >> 5); scr[kk * 33 + (lane & 31)] = W[(size_t)(k0 + kk) * ldw + col0 + n0 + (lane & 31)]; }
    asm volatile("s_waitcnt lgkmcnt(0)" ::: "memory");
    const int c = lane & 7;
#pragma unroll
    for (int j = 0; j < 4; ++j) { const int n = (lane >> 3) + 8 * j; const LAS float* s = scr + (8 * c) * 33 + n;
        u32x4 o; o.x = cvt_pk_bf16(s[0 * 33], s[1 * 33]); o.y = cvt_pk_bf16(s[2 * 33], s[3 * 33]); o.z = cvt_pk_bf16(s[4 * 33], s[5 * 33]); o.w = cvt_pk_bf16(s[6 * 33], s[7 * 33]);
        *(u32x4*)(WT + (size_t)(drow0 + n0 + n) * K + k0 + 8 * c) = o; }
    asm volatile("s_waitcnt lgkmcnt(0)" ::: "memory");
}
__device__ __forceinline__ void convert_weights(Frame& F, int l) {
    LAS float* scr = (LAS float*)(F.lds + F.wave * 8448);
    const int gw = F.bid * NWAVES + F.wave, NGW = F.G * NWAVES;
    const float* win = F.in[I_WIN] + (size_t)l * D * INW;
    bf16_t* WT = F.WT;
    for (int it = gw; it < 8448; it += NGW) {
        int r = it;
        if (r < 256) { tr_item(win, INW, W_Q, 16, WT + WT_NAT, 1024, 0, scr, r, F.lane); continue; } r -= 256;
        if (r < 256) { tr_item(win, INW, W_K, 16, WT + WT_NAT, 1024, 512, scr, r, F.lane); continue; } r -= 256;
        if (r < 128) { tr_item(win, INW, W_POOL, 8, WT + WT_NAT, 1024, 1024, scr, r, F.lane); continue; } r -= 128;
        if (r < 256) { tr_item(win, INW, W_CONV, 16, WT + WT_NAT, 1024, 1280, scr, r, F.lane); continue; } r -= 256;
        if (r < 256) { tr_item(win, INW, W_V, 16, WT + WT_V, 1024, 0, scr, r, F.lane); continue; } r -= 256;
        if (r < 2048) { tr_item(win, INW, W_GATE, 128, WT + WT_G, 1024, 0, scr, r, F.lane); continue; } r -= 2048;
        if (r < 256) { tr_item(F.in[I_WBA] + (size_t)l * 512 * D, D, 0, 32, WT + WT_BA, 512, 0, scr, r, F.lane); continue; } r -= 256;
        if (r < 128) { tr_item(F.in[I_WBP] + (size_t)l * 256 * D, D, 0, 32, WT + WT_BP, 256, 0, scr, r, F.lane); continue; } r -= 128;
        if (r < 128) { tr_item(F.in[I_WBF] + (size_t)l * 256 * D, D, 0, 32, WT + WT_BF, 256, 0, scr, r, F.lane); continue; } r -= 128;
        if (r < 128) { tr_item(F.in[I_WBC] + (size_t)l * 256 * D, D, 0, 32, WT + WT_BC, 256, 0, scr, r, F.lane); continue; } r -= 128;
        if (r < 512) { tr_item(F.in[I_WOUT] + (size_t)l * D * D, D, 0, 32, WT + WT_O, 1024, 0, scr, r, F.lane); continue; } r -= 512;
        if (r < 2048) { tr_item(F.in[I_WFF1] + (size_t)l * D * DFF, DFF, 0, 128, WT + WT_1, 1024, 0, scr, r, F.lane); continue; } r -= 2048;
        tr_item(F.in[I_WFF2] + (size_t)l * DFF * D, D, 0, 32, WT + WT_2, 4096, 0, scr, r, F.lane);
    }
    __syncthreads();
    LAS float* st = (LAS float*)F.lds;
    LAS float* ct = (LAS float*)(F.lds + 64 * 65 * 4);
    for (int it = F.bid; it < 256; it += F.G) {
        const int g = it >> 6, k0 = ((it >> 2) & 15) * 64, jq = it & 3;
        for (int i = F.tid; i < 64 * 64; i += NT) { const int kk = i >> 6, cch = i & 63; st[kk * 65 + cch] = win[(size_t)(k0 + kk) * INW + W_FOUR + 64 * g + cch]; }
        if (F.tid < 64) { const float ang = 6.283185307179586f * (float)F.tid / 64.0f; ct[F.tid] = cosf(ang); ct[64 + F.tid] = sinf(ang); }
        __syncthreads();
        const int kk = F.tid & 63, jg = F.tid >> 6;
        for (int jj = 0; jj < 4; ++jj) {
            const int jp = 32 * jq + 4 * jg + jj, ri = jp >> 6, cp = jp & 63; float a = 0.f;
            for (int cch = 0; cch < 64; ++cch) a += st[kk * 65 + cch] * ct[ri * 64 + ((cch * cp) & 63)];
            a *= ri ? -0.125f : 0.125f;
            WT[WT_F + (size_t)(ri * 256 + g * 64 + cp) * 1024 + k0 + kk] = f2bf(a);
        }
        __syncthreads();
    }
}

__device__ __forceinline__ void norm_mod_rows(Frame& F, int l, const float* xl  , const float* xc, float* xcw, const float* pb, int nsplit, const float* pgate,
                                              const float* g, int ch_shift, int ch_scale, int nrows) {
    const int gw = F.bid * NWAVES + F.wave, NGW = F.G * NWAVES;
    for (int m = gw; m < nrows; m += NGW) {
        const bool isc = m >= ML;
        const int mi = row_mi(m);
        const float* sh = mod_ptr(F, l, mi, ch_shift); const float* sc = mod_ptr(F, l, mi, ch_scale);
        f32x4 v[4]; float s = 0.f;
        if (isc || xl != nullptr) {
            const float* xrow = (!isc) ? xl + (size_t)m * D : xc + (size_t)(m - ML) * D;
#pragma unroll
            for (int j = 0; j < 4; ++j) v[j] = *((const f32x4*)xrow + F.lane + 64 * j);
            if (!isc) {
#pragma unroll
                for (int j = 0; j < 4; ++j) *((u32x2*)(F.XB + (size_t)m * D) + F.lane + 64 * j) = (u32x2){cvt_pk_bf16(v[j].x, v[j].y), cvt_pk_bf16(v[j].z, v[j].w)};
            }
        } else {
#pragma unroll
            for (int j = 0; j < 4; ++j) { const u32x2 w = __builtin_nontemporal_load((const u32x2*)(F.XB + (size_t)m * D) + F.lane + 64 * j); v[j] = (f32x4){bflo(w.x), bfhi(w.x), bflo(w.y), bfhi(w.y)}; }
        }
        if (isc && nsplit > 0) {
            f32x4 a[4];
#pragma unroll
            for (int j = 0; j < 4; ++j) a[j] = (f32x4){0.f, 0.f, 0.f, 0.f};
            for (int sp = 0; sp < nsplit; ++sp) {
                const f32x4* pr = (const f32x4*)(pb + ((size_t)sp * MC + (m - ML)) * D) + F.lane;
#pragma unroll
                for (int j = 0; j < 4; ++j) a[j] += pr[64 * j];
            }
#pragma unroll
            for (int j = 0; j < 4; ++j) v[j] += a[j] * *((const f32x4*)pgate + F.lane + 64 * j);
        }
        if (isc && (nsplit > 0 || xc != xcw)) {
#pragma unroll
            for (int j = 0; j < 4; ++j) *((f32x4*)(xcw + (size_t)(m - ML) * D) + F.lane + 64 * j) = v[j];
        }
#pragma unroll
        for (int j = 0; j < 4; ++j) s += (v[j].x * v[j].x + v[j].y * v[j].y) + (v[j].z * v[j].z + v[j].w * v[j].w);
        const float rstd = 1.0f / sqrtf(wave_sum(s) * (1.0f / D) + 1e-6f);
        unsigned long long* o8 = (unsigned long long*)(F.H + (size_t)m * D) + F.lane;
#pragma unroll
        for (int j = 0; j < 4; ++j) {
            const f32x4 gg = *((const f32x4*)g + F.lane + 64 * j), s1 = *((const f32x4*)sh + F.lane + 64 * j), s2 = *((const f32x4*)sc + F.lane + 64 * j);
            const float a0 = (v[j].x * rstd * gg.x) * (1.0f + s2.x) + s1.x, a1 = (v[j].y * rstd * gg.y) * (1.0f + s2.y) + s1.y;
            const float a2 = (v[j].z * rstd * gg.z) * (1.0f + s2.z) + s1.z, a3 = (v[j].w * rstd * gg.w) * (1.0f + s2.w) + s1.w;
            o8[64 * j] = (unsigned long long)cvt_pk_bf16(a0, a1) | ((unsigned long long)cvt_pk_bf16(a2, a3) << 32);
        }
    }
}
__device__ __forceinline__ void final_norm(Frame& F) {
    const int gw = F.bid * NWAVES + F.wave, NGW = F.G * NWAVES; const float* g = F.in[I_GFINAL];
    for (int m = gw; m < ML; m += NGW) {
        float* orow = F.out + (size_t)m * D;
        f32x4 v[4]; float s = 0.f;
#pragma unroll
        for (int j = 0; j < 4; ++j) { const u32x2 w = *((const u32x2*)(F.XB + (size_t)m * D) + F.lane + 64 * j); v[j] = (f32x4){bflo(w.x), bfhi(w.x), bflo(w.y), bfhi(w.y)};
            s += (v[j].x * v[j].x + v[j].y * v[j].y) + (v[j].z * v[j].z + v[j].w * v[j].w); }
        const float rstd = 1.0f / sqrtf(wave_sum(s) * (1.0f / D) + 1e-6f);
#pragma unroll
        for (int j = 0; j < 4; ++j) { const f32x4 gg = *((const f32x4*)g + F.lane + 64 * j); *((f32x4*)orow + F.lane + 64 * j) = (f32x4){v[j].x * rstd * gg.x, v[j].y * rstd * gg.y, v[j].z * rstd * gg.z, v[j].w * rstd * gg.w}; }
    }
}

struct Order1 {
    int G, c; const char* H; const char* WT; int nctxg;
    __device__ __forceinline__ bool next(int i, Unit& u) const {
        u.lda = 1024; u.ldb = 1024; u.nt = 16;
        int L = i * G + c; if (L >= 924 + 264 + 8 + nctxg) return false;
        if (L >= 924 + 264 + 8) { L -= 924 + 264 + 8; u.pm = L >> 4; u.pn = L & 15; u.kind = 3; u.a = H + (size_t)(ML + u.pm * 256) * 2048; u.b = WT + (WT_G + (size_t)u.pn * 256 * 1024) * 2; return true; }
        if (L < 924) { pg8::tile_map(L, 132, 7, u.pm, u.pn); u.kind = 0; u.a = H + (size_t)u.pm * 256 * 2048; u.b = WT + (WT_NAT + (size_t)u.pn * 256 * 1024) * 2; return true; }
        L -= 924;
        if (L < 264) { u.pm = L / 132; u.pn = L % 132; u.kind = 1; u.a = WT + (WT_V + (size_t)u.pm * 256 * 1024) * 2; u.b = H + (size_t)u.pn * 256 * 2048; return true; }
        L -= 264; u.pm = L >> 2; u.pn = L & 3; u.kind = 2; u.a = WT + (WT_F + (size_t)u.pm * 256 * 1024) * 2; u.b = H + (size_t)(ML + u.pn * 256) * 2048; return true;
    }
};
struct Epi1 {
    static constexpr bool PERM = true;
    bf16_t* P; bf16_t* VT; bf16_t* ZC; const f32x2* rope; bf16_t* GC;
    __device__ __forceinline__ void rows(f32x4 (&acc)[2][2][4][2], int ai, int m, bf16_t* base, int ldc, int wr, int wc, int fr, int fq, bool do_rope, const f32x2 (&cs)[8], float qs, bool sig) const {
        const int rt = ai * 128 + wr * 64 + m * 16 + fr;
#pragma unroll
        for (int bj = 0; bj < 2; ++bj) {
            f32x4 v0 = acc[ai][bj][m][0], v1 = acc[ai][bj][m][1];
            if (do_rope) {
                const float sg = (fq < 2) ? -1.0f : 1.0f;
#pragma unroll
                for (int j = 0; j < 4; ++j) {
                    const float p0 = __shfl_xor(v0[j], 32), p1 = __shfl_xor(v1[j], 32);
                    v0[j] = v0[j] * cs[j].x + sg * p0 * cs[j].y; v1[j] = v1[j] * cs[4 + j].x + sg * p1 * cs[4 + j].y;
                }
            }
            v0 *= qs; v1 *= qs;
            if (sig) {
#pragma unroll
                for (int j = 0; j < 4; ++j) { v0[j] = sigmoidf_(v0[j]); v1[j] = sigmoidf_(v1[j]); }
            }
            u32x4 w; w.x = cvt_pk_bf16(v0[0], v0[1]); w.y = cvt_pk_bf16(v0[2], v0[3]); w.z = cvt_pk_bf16(v1[0], v1[1]); w.w = cvt_pk_bf16(v1[2], v1[3]);
            *(u32x4*)(base + (size_t)rt * ldc + bj * 128 + wc * 32 + 8 * fq) = w;
        }
        asm volatile("" ::: "memory");
    }
    __device__ __forceinline__ void load_cs(f32x2 (&cs)[8], int pos, int fq) const {
        const f32x4* tp = (const f32x4*)(rope + pos * 16 + 8 * (fq & 1));
#pragma unroll
        for (int q = 0; q < 4; ++q) { const f32x4 t = tp[q]; cs[2 * q] = (f32x2){t.x, t.y}; cs[2 * q + 1] = (f32x2){t.z, t.w}; }
    }
    __device__ __forceinline__ void operator()(f32x4 (&acc)[2][2][4][2], const Unit& u, int wr, int wc, int fr_, int fq_) const {
        int fr = fr_, fq = fq_; asm volatile("" : "+v"(fr), "+v"(fq));
        bf16_t* base; int ldc;
        if (u.kind == 0) { base = P + (size_t)u.pm * 256 * LDP + u.pn * 256; ldc = LDP; }
        else if (u.kind == 1) { base = VT + (size_t)u.pm * 256 * M + u.pn * 256; ldc = M; }
        else if (u.kind == 3) { base = GC + (size_t)u.pm * 256 * 4096 + u.pn * 256; ldc = 4096; }
        else { base = ZC + (size_t)u.pm * 256 * 1024 + u.pn * 256; ldc = 1024; }
        const bool do_rope = (u.kind == 0) && (u.pm < 128) && (u.pn < 4);
        const float qs = ((u.kind == 0) && (u.pn < 2)) ? 0.18033688011112042f : 1.0f;
        const bool sig = (u.kind == 3);
        if (do_rope && (wc & 1)) {
            f32x2 cs[4][8];
#pragma unroll
            for (int m = 0; m < 4; ++m) load_cs(cs[m], m * 16 + fr, fq);
#pragma unroll
            for (int m = 0; m < 4; ++m)
#pragma unroll
                for (int ai = 0; ai < 2; ++ai) rows(acc, ai, m, base, ldc, wr, wc, fr, fq, true, cs[m], qs, false);
        } else if (do_rope) {
            f32x2 cs[2][8];
#pragma unroll
            for (int ai = 0; ai < 2; ++ai) load_cs(cs[ai], (u.pm * 4 + ai * 2 + wr) & 127, fq);
#pragma unroll
            for (int ai = 0; ai < 2; ++ai)
#pragma unroll
                for (int m = 0; m < 4; ++m) rows(acc, ai, m, base, ldc, wr, wc, fr, fq, true, cs[ai], qs, false);
        } else {
            f32x2 cs[8];
#pragma unroll
            for (int j = 0; j < 8; ++j) cs[j] = (f32x2){1.f, 0.f};
#pragma unroll
            for (int ai = 0; ai < 2; ++ai)
#pragma unroll
                for (int m = 0; m < 4; ++m) rows(acc, ai, m, base, ldc, wr, wc, fr, fq, false, cs, qs, sig);
        }
    }
};
struct Order2 {
    int G, c; const char* H; const char* WT;
    __device__ __forceinline__ bool next(int i, Unit& u) const {
        u.lda = 1024; u.ldb = 64 * 1024; u.nt = 16;
        const int L = i * G + c; if (L >= 256) return false;
        const int n2 = L >> 2; u.pm = (L >> 1) & 1; u.pn = L & 1; u.kind = n2;
        u.a = WT + (WT_F + (size_t)u.pm * 256 * 1024) * 2; u.b = H + ((size_t)n2 + (size_t)64 * 256 * u.pn) * 2048; return true;
    }
};
struct EpiPlain {
    static constexpr bool PERM = true;
    bf16_t* base; int ldc; size_t kstride; int relu2;
    __device__ __forceinline__ void operator()(f32x4 (&acc)[2][2][4][2], const Unit& u, int wr, int wc, int fr_, int fq_) const {
        int fr = fr_, fq = fq_; asm volatile("" : "+v"(fr), "+v"(fq));
        bf16_t* b0 = base + (size_t)u.kind * kstride + (size_t)u.pm * 256 * ldc + u.pn * 256;
#pragma unroll
        for (int ai = 0; ai < 2; ++ai)
#pragma unroll
            for (int m = 0; m < 4; ++m) {
                const int rt = ai * 128 + wr * 64 + m * 16 + fr;
#pragma unroll
                for (int bj = 0; bj < 2; ++bj) {
                    f32x4 v0 = acc[ai][bj][m][0], v1 = acc[ai][bj][m][1];
                    if (relu2) {
#pragma unroll
                        for (int j = 0; j < 4; ++j) { const float a = fmaxf(v0[j], 0.f), b = fmaxf(v1[j], 0.f); v0[j] = a * a; v1[j] = b * b; }
                    }
                    u32x4 w; w.x = cvt_pk_bf16(v0[0], v0[1]); w.y = cvt_pk_bf16(v0[2], v0[3]); w.z = cvt_pk_bf16(v1[0], v1[1]); w.w = cvt_pk_bf16(v1[2], v1[3]);
                    *(u32x4*)(b0 + (size_t)rt * ldc + bj * 128 + wc * 32 + 8 * fq) = w;
                }
            }
    }
};
struct OrderN {
    int G, c, nM, nN, nbr, lda, ldb; const char* A0; const char* B0; size_t astride, bstride;
    __device__ __forceinline__ bool next(int i, Unit& u) const {
        u.lda = lda; u.ldb = ldb; u.nt = lda / 64;
        int L = i * G + c; const int per = nM * nN; if (L >= per * nbr) return false;
        const int br = L / per; L -= br * per;
        pg8::tile_map(L, nM, nN, u.pm, u.pn); u.kind = br;
        u.a = A0 + br * astride + (size_t)u.pm * 256 * lda * 2; u.b = B0 + br * bstride + (size_t)u.pn * 256 * ldb * 2; return true;
    }
};
struct OrderG {
    int G, c, nctx; const char* H; const char* WG;
    __device__ __forceinline__ bool next(int i, Unit& u) const {
        u.lda = 1024; u.ldb = 1024; u.nt = 16;
        const int ng = (512 - c + G - 1) / G;
        if (i < 4 * ng) { const int t = (i >> 2) * G + c; int pno; pg8::tile_map(t, 128, 4, u.pm, pno); const int b = i & 3; u.kind = b; u.pn = pno;
            u.a = H + (size_t)u.pm * 256 * 2048; u.b = WG + (size_t)(b * 4 + pno) * 256 * 2048; return true; }
        const int j = (i - 4 * ng) * G + c; if (j >= nctx) return false;
        const int b = j & 3, pno = (j >> 2) & 3; u.pm = 128 + (j >> 4); u.pn = pno; u.kind = 4 + b;
        u.a = H + (size_t)u.pm * 256 * 2048; u.b = WG + (size_t)(b * 4 + pno) * 256 * 2048; return true;
    }
};
struct EpiGate {
    static constexpr bool PERM = true;
    const bf16_t* Y; bf16_t* MG;
    __device__ __forceinline__ void operator()(f32x4 (&acc)[2][2][4][2], const Unit& u, int wr, int wc, int fr_, int fq_) const {
        int fr = fr_, fq = fq_; asm volatile("" : "+v"(fr), "+v"(fq));
        const int b = u.kind & 3; const bool inplace = u.kind >= 4;
#pragma unroll
        for (int ai = 0; ai < 2; ++ai)
#pragma unroll
            for (int m = 0; m < 4; ++m) {
                const size_t row = (size_t)u.pm * 256 + ai * 128 + wr * 64 + m * 16 + fr;
#pragma unroll
                for (int bj = 0; bj < 2; ++bj) {
                    const int col = u.pn * 256 + bj * 128 + wc * 32 + 8 * fq;
                    const u32x4 yv = __builtin_nontemporal_load((const u32x4*)(Y + row * 4096 + b * 1024 + col));
                    u32x4 mv = (u32x4){0u, 0u, 0u, 0u};
                    if (b > 0 && !inplace) mv = *(const u32x4*)(MG + row * 1024 + col);
                    const f32x4 v0 = acc[ai][bj][m][0], v1 = acc[ai][bj][m][1];
                    float r[8];
                    r[0] = sigmoidf_(v0[0]) * bflo(yv.x) + bflo(mv.x); r[1] = sigmoidf_(v0[1]) * bfhi(yv.x) + bfhi(mv.x);
                    r[2] = sigmoidf_(v0[2]) * bflo(yv.y) + bflo(mv.y); r[3] = sigmoidf_(v0[3]) * bfhi(yv.y) + bfhi(mv.y);
                    r[4] = sigmoidf_(v1[0]) * bflo(yv.z) + bflo(mv.z); r[5] = sigmoidf_(v1[1]) * bfhi(yv.z) + bfhi(mv.z);
                    r[6] = sigmoidf_(v1[2]) * bflo(yv.w) + bflo(mv.w); r[7] = sigmoidf_(v1[3]) * bfhi(yv.w) + bfhi(mv.w);
                    u32x4 w; w.x = cvt_pk_bf16(r[0], r[1]); w.y = cvt_pk_bf16(r[2], r[3]); w.z = cvt_pk_bf16(r[4], r[5]); w.w = cvt_pk_bf16(r[6], r[7]);
                    if (inplace) *(u32x4*)(Y + row * 4096 + b * 1024 + col) = w; else *(u32x4*)(MG + row * 1024 + col) = w;
                }
            }
    }
};
struct OrderF {
    int G, c, nctx; const char* H; const char* WT; const char* R2;
    __device__ __forceinline__ bool next(int i, Unit& u) const {
        const int ng = (512 - c + G - 1) / G;
        int pm, pno, b, isg; bool ctx;
        if (i < 8 * ng) { const int t = (i >> 3) * G + c; pg8::tile_map(t, 128, 4, pm, pno); const int sub = i & 7; b = sub >> 1; isg = sub & 1; ctx = false; }
        else { const int ii = i - 8 * ng, pr = ii * G + c; if (pr >= nctx) return false; isg = 0; b = pr & 3; pno = (pr >> 2) & 3; pm = 128 + (pr >> 4); ctx = true; }
        u.pm = pm; u.pn = pno;
        if (isg) { u.kind = (ctx ? 4 : 0) + b; u.a = H + (size_t)pm * 256 * 2048; u.lda = 1024; u.b = WT + (WT_G + (size_t)(b * 4 + pno) * 256 * 1024) * 2; u.ldb = 1024; u.nt = 16; }
        else {
            const int Kb = (b == 0) ? 512 : 256;
            const size_t aoffb = (b == 0) ? R2_ATTN : (b == 1 ? R2_POOL : (b == 2 ? R2_FOUR : R2_CONV));
            const size_t woff = (b == 0) ? WT_BA : (b == 1 ? WT_BP : (b == 2 ? WT_BF : WT_BC));
            u.kind = (ctx ? 12 : 8) + b; u.a = R2 + aoffb + (size_t)pm * 256 * Kb * 2; u.lda = Kb; u.b = WT + (woff + (size_t)pno * 256 * Kb) * 2; u.ldb = Kb; u.nt = Kb / 64;
        }
        return true;
    }
};
struct EpiFused {
    static constexpr bool PERM = true;
    bf16_t* MG; bf16_t* GYc; unsigned char* scr; const bf16_t* GC;
    __device__ __forceinline__ void operator()(f32x4 (&acc)[2][2][4][2], const Unit& u, int wr, int wc, int fr_, int fq_) const {
        int fr = fr_, fq = fq_; asm volatile("" : "+v"(fr), "+v"(fq));
        u32x4* slot = (u32x4*)scr + ((wr * 4 + wc) * 64 + fq * 16 + fr);
        if (u.kind >= 12) {
            const int b = u.kind & 3;
#pragma unroll
            for (int ai = 0; ai < 2; ++ai) {
                u32x4 gq[4][2];
#pragma unroll
                for (int m = 0; m < 4; ++m)
#pragma unroll
                    for (int bj = 0; bj < 2; ++bj)
                        gq[m][bj] = *(const u32x4*)(GC + ((size_t)(u.pm - 128) * 256 + ai * 128 + wr * 64 + m * 16 + fr) * 4096 + b * 1024 + u.pn * 256 + bj * 128 + wc * 32 + 8 * fq);
#pragma unroll
                for (int m = 0; m < 4; ++m)
#pragma unroll
                    for (int bj = 0; bj < 2; ++bj) {
                        const size_t off = ((size_t)(u.pm - 128) * 256 + ai * 128 + wr * 64 + m * 16 + fr) * 4096 + b * 1024 + u.pn * 256 + bj * 128 + wc * 32 + 8 * fq;
                        const u32x4 gv = gq[m][bj];
                        const f32x4 v0 = acc[ai][bj][m][0], v1 = acc[ai][bj][m][1];
                        u32x4 w; w.x = cvt_pk_bf16(v0[0] * bflo(gv.x), v0[1] * bfhi(gv.x)); w.y = cvt_pk_bf16(v0[2] * bflo(gv.y), v0[3] * bfhi(gv.y));
                        w.z = cvt_pk_bf16(v1[0] * bflo(gv.z), v1[1] * bfhi(gv.z)); w.w = cvt_pk_bf16(v1[2] * bflo(gv.w), v1[3] * bfhi(gv.w));
                        *(u32x4*)(GYc + off) = w;
                    }
                asm volatile("" ::: "memory");
            }
            return;
        }
        if (u.kind >= 8) {
#pragma unroll
            for (int ai = 0; ai < 2; ++ai)
#pragma unroll
                for (int m = 0; m < 4; ++m)
#pragma unroll
                    for (int bj = 0; bj < 2; ++bj) {
                        const f32x4 v0 = acc[ai][bj][m][0], v1 = acc[ai][bj][m][1];
                        u32x4 w; w.x = cvt_pk_bf16(v0[0], v0[1]); w.y = cvt_pk_bf16(v0[2], v0[3]); w.z = cvt_pk_bf16(v1[0], v1[1]); w.w = cvt_pk_bf16(v1[2], v1[3]);
                        slot[((ai * 4 + m) * 2 + bj) * 512] = w;
                    }
            return;
        }
        const int b = u.kind & 3; const bool inplace = u.kind >= 4;
#pragma unroll
        for (int ai = 0; ai < 2; ++ai) {
            u32x4 yv[4][2], mv[4][2];
#pragma unroll
            for (int m = 0; m < 4; ++m)
#pragma unroll
                for (int bj = 0; bj < 2; ++bj) {
                    yv[m][bj] = slot[((ai * 4 + m) * 2 + bj) * 512];
                    mv[m][bj] = (u32x4){0u, 0u, 0u, 0u};
                    if (b > 0 && !inplace) mv[m][bj] = *(const u32x4*)(MG + ((size_t)u.pm * 256 + ai * 128 + wr * 64 + m * 16 + fr) * 1024 + u.pn * 256 + bj * 128 + wc * 32 + 8 * fq);
                }
#pragma unroll
            for (int m = 0; m < 4; ++m) {
                const size_t row = (size_t)u.pm * 256 + ai * 128 + wr * 64 + m * 16 + fr;
#pragma unroll
                for (int bj = 0; bj < 2; ++bj) {
                    const int col = u.pn * 256 + bj * 128 + wc * 32 + 8 * fq;
                    const u32x4 y4 = yv[m][bj], m4 = mv[m][bj];
                    const f32x4 v0 = acc[ai][bj][m][0], v1 = acc[ai][bj][m][1];
                    float r[8];
                    r[0] = sigmoidf_(v0[0]) * bflo(y4.x) + bflo(m4.x); r[1] = sigmoidf_(v0[1]) * bfhi(y4.x) + bfhi(m4.x);
                    r[2] = sigmoidf_(v0[2]) * bflo(y4.y) + bflo(m4.y); r[3] = sigmoidf_(v0[3]) * bfhi(y4.y) + bfhi(m4.y);
                    r[4] = sigmoidf_(v1[0]) * bflo(y4.z) + bflo(m4.z); r[5] = sigmoidf_(v1[1]) * bfhi(y4.z) + bfhi(m4.z);
                    r[6] = sigmoidf_(v1[2]) * bflo(y4.w) + bflo(m4.w); r[7] = sigmoidf_(v1[3]) * bfhi(y4.w) + bfhi(m4.w);
                    u32x4 w; w.x = cvt_pk_bf16(r[0], r[1]); w.y = cvt_pk_bf16(r[2], r[3]); w.z = cvt_pk_bf16(r[4], r[5]); w.w = cvt_pk_bf16(r[6], r[7]);
                    if (inplace) *(u32x4*)(GYc + (row - ML) * 4096 + b * 1024 + col) = w; else *(u32x4*)(MG + row * 1024 + col) = w;
                }
            }
            asm volatile("" ::: "memory");
        }
    }
};
struct OrderMini {
    int G, c, nsplit, kchunk, lda, ldb, bwrap; const char* A0; const char* B0;
    __device__ __forceinline__ bool next(int i, Unit& u) const {
        u.lda = lda; u.ldb = ldb; u.nt = kchunk / 64;
        const int j = i * G + c; if (j >= 16 * nsplit) return false;
        const int kc = j >> 4; u.pm = (j >> 2) & 3; u.pn = j & 3; u.kind = kc;
        u.a = A0 + ((size_t)u.pm * 256 * lda + (size_t)kc * kchunk) * 2; u.b = B0 + ((size_t)u.pn * 256 * ldb + (size_t)((kc * kchunk) % bwrap)) * 2; return true;
    }
};
struct EpiPartial {
    static constexpr bool PERM = false;
    float* PB;
    __device__ __forceinline__ void operator()(f32x4 (&acc)[2][2][4][2], const Unit& u, int wr, int wc, int fr_, int fq_) const {
        int fr = fr_, fq = fq_; asm volatile("" : "+v"(fr), "+v"(fq));
        float* base = PB + ((size_t)u.kind * MC + (size_t)u.pm * 256) * D + u.pn * 256 + wc * 32 + 4 * fq;
#pragma unroll
        for (int ai = 0; ai < 2; ++ai)
#pragma unroll
            for (int m = 0; m < 4; ++m) {
                const size_t ro = (size_t)(ai * 128 + wr * 64 + m * 16 + fr) * D;
#pragma unroll
                for (int bj = 0; bj < 2; ++bj)
#pragma unroll
                    for (int n = 0; n < 2; ++n) *(f32x4*)(base + ro + bj * 128 + n * 16) = acc[ai][bj][m][n];
            }
    }
};
struct EpiRes {
    static constexpr bool PERM = true;
    bf16_t* XB; const float* MODL; int chunk;
    __device__ __forceinline__ void operator()(f32x4 (&acc)[2][2][4][2], const Unit& u, int wr, int wc, int fr_, int fq_) const {
        int fr = fr_, fq = fq_; asm volatile("" : "+v"(fr), "+v"(fq));
        const int mi = tile_mi(u.pm);
        const float* gt = MODL + ((size_t)mi * 6 + chunk) * D + u.pn * 256 + wc * 32 + 8 * fq;
        bf16_t* xp = XB + (size_t)u.pm * 256 * D + u.pn * 256 + wc * 32 + 8 * fq;
        f32x4 gv[2][2];
#pragma unroll
        for (int bj = 0; bj < 2; ++bj)
#pragma unroll
            for (int n = 0; n < 2; ++n) gv[bj][n] = *(const f32x4*)(gt + bj * 128 + n * 4);
#pragma unroll
        for (int ai = 0; ai < 2; ++ai) {
            u32x4 xo[4][2];
#pragma unroll
            for (int m = 0; m < 4; ++m)
#pragma unroll
                for (int bj = 0; bj < 2; ++bj) xo[m][bj] = *(const u32x4*)(xp + (size_t)(ai * 128 + wr * 64 + m * 16 + fr) * D + bj * 128);
#pragma unroll
            for (int m = 0; m < 4; ++m) {
                const size_t ro = (size_t)(ai * 128 + wr * 64 + m * 16 + fr) * D;
#pragma unroll
                for (int bj = 0; bj < 2; ++bj) {
                    const u32x4 x0 = xo[m][bj];
                    const f32x4 a0 = acc[ai][bj][m][0] * gv[bj][0], a1 = acc[ai][bj][m][1] * gv[bj][1];
                    u32x4 w; w.x = cvt_pk_bf16(bflo(x0.x) + a0[0], bfhi(x0.x) + a0[1]); w.y = cvt_pk_bf16(bflo(x0.y) + a0[2], bfhi(x0.y) + a0[3]);
                    w.z = cvt_pk_bf16(bflo(x0.z) + a1[0], bfhi(x0.z) + a1[1]); w.w = cvt_pk_bf16(bflo(x0.w) + a1[2], bfhi(x0.w) + a1[3]);
                    *(u32x4*)(xp + ro + bj * 128) = w;
                }
            }
            asm volatile("" ::: "memory");
        }
    }
};

constexpr int AT_STR = 144, AT_TILE = 64 * AT_STR, AT_BUF = 2 * AT_TILE, AT_RPB = 5 * AT_BUF;
template <bool CTX>
__device__ __forceinline__ void attn_step(const LAS unsigned char* kt, const LAS unsigned char* vt, const LAS float* rpb, const bf16x8 (&q)[2], f32x4 (&o)[4], float& mrun, float& lrun,
                                          const int g, const int drow, const int fr, const int fq) {
    constexpr int NTL = CTX ? 4 : 2;
    const int kc0 = CTX ? 0 : (g == 0 ? 0 : (g == 1 ? 8 : (g == 2 ? 24 : 32)));
    f32x4 s[NTL];
#pragma unroll
    for (int t = 0; t < NTL; ++t) {
        s[t] = (f32x4){0.f, 0.f, 0.f, 0.f};
#pragma unroll
        for (int kb = 0; kb < 2; ++kb) { const bf16x8 ka = *(const LAS bf16x8*)(kt + (kc0 + 16 * t + fr) * AT_STR + kb * 64 + fq * 16); s[t] = MFMA16(ka, q[kb], s[t]); }
    }
    if (!CTX) {
        const int c = 16 * g + fr; const int cs = min(max(c - 8, 0), 48); const int delta = cs - kc0;
        bool sel[4];
#pragma unroll
        for (int r = 0; r < 4; ++r) {
            const int i = 4 * fq + r; sel[r] = (i >= delta);
            const int kc = kc0 + i + (sel[r] ? 0 : 16);
            s[0][r] = (sel[r] ? s[0][r] : s[1][r]) + rpb[drow * 31 + (kc - c + 15)];
        }
        float mx = fmaxf(fmaxf(s[0][0], s[0][1]), fmaxf(s[0][2], s[0][3]));
        mx = fmaxf(mx, __shfl_xor(mx, 16)); mx = fmaxf(mx, __shfl_xor(mx, 32));
        const float mn = fmaxf(mrun, mx), alpha = __builtin_amdgcn_exp2f(mrun - mn);
        float ps = 0.f;
#pragma unroll
        for (int r = 0; r < 4; ++r) { s[0][r] = __builtin_amdgcn_exp2f(s[0][r] - mn); ps += s[0][r]; }
        lrun = lrun * alpha + ps; mrun = mn;
#pragma unroll
        for (int dt = 0; dt < 4; ++dt) o[dt] *= alpha;
        u32x4 pw;
        pw.x = cvt_pk_bf16(sel[0] ? s[0][0] : 0.f, sel[1] ? s[0][1] : 0.f); pw.y = cvt_pk_bf16(sel[2] ? s[0][2] : 0.f, sel[3] ? s[0][3] : 0.f);
        pw.z = cvt_pk_bf16(sel[0] ? 0.f : s[0][0], sel[1] ? 0.f : s[0][1]); pw.w = cvt_pk_bf16(sel[2] ? 0.f : s[0][2], sel[3] ? 0.f : s[0][3]);
        const bf16x8 pk = __builtin_bit_cast(bf16x8, pw);
#pragma unroll
        for (int dt = 0; dt < 4; ++dt) {
            const LAS unsigned char* vp = vt + (16 * dt + fr) * AT_STR + (kc0 + 4 * fq) * 2;
            const u32x2 lo = *(const LAS u32x2*)vp, hi = *(const LAS u32x2*)(vp + 32);
            const u32x4 vw = (u32x4){lo.x, lo.y, hi.x, hi.y};
            o[dt] = MFMA16(__builtin_bit_cast(bf16x8, vw), pk, o[dt]);
        }
        return;
    }
    float mx = s[0][0];
#pragma unroll
    for (int t = 0; t < NTL; ++t)
#pragma unroll
        for (int r = 0; r < 4; ++r) mx = fmaxf(mx, s[t][r]);
    mx = fmaxf(mx, __shfl_xor(mx, 16)); mx = fmaxf(mx, __shfl_xor(mx, 32));
    const float mn = fmaxf(mrun, mx), alpha = __builtin_amdgcn_exp2f(mrun - mn);
    float ps = 0.f;
#pragma unroll
    for (int t = 0; t < NTL; ++t)
#pragma unroll
        for (int r = 0; r < 4; ++r) { s[t][r] = __builtin_amdgcn_exp2f(s[t][r] - mn); ps += s[t][r]; }
    lrun = lrun * alpha + ps; mrun = mn;
#pragma unroll
    for (int dt = 0; dt < 4; ++dt) o[dt] *= alpha;
#pragma unroll
    for (int k2 = 0; k2 < NTL / 2; ++k2) {
        u32x4 pw; pw.x = cvt_pk_bf16(s[2 * k2][0], s[2 * k2][1]); pw.y = cvt_pk_bf16(s[2 * k2][2], s[2 * k2][3]); pw.z = cvt_pk_bf16(s[2 * k2 + 1][0], s[2 * k2 + 1][1]); pw.w = cvt_pk_bf16(s[2 * k2 + 1][2], s[2 * k2 + 1][3]);
        const bf16x8 pk = __builtin_bit_cast(bf16x8, pw);
#pragma unroll
        for (int dt = 0; dt < 4; ++dt) {
            const LAS unsigned char* vp = vt + (16 * dt + fr) * AT_STR + (kc0 + 32 * k2 + 4 * fq) * 2;
            const u32x2 lo = *(const LAS u32x2*)vp, hi = *(const LAS u32x2*)(vp + 32);
            const u32x4 vw = (u32x4){lo.x, lo.y, hi.x, hi.y};
            o[dt] = MFMA16(__builtin_bit_cast(bf16x8, vw), pk, o[dt]);
        }
    }
}
__device__ __forceinline__ void attn_unit(Frame& F, int l, int b, int h, int rb) {
    const bool cu = rb < 0;
    const int w = F.wave, fr = F.lane & 15, fq = F.lane >> 4, gh = w & 1;
    const int r0 = cu ? 0 : 4 * rb;
    const int lo = min(max(r0 - 4, 0), 120), rs3 = min(max(r0 - 1, 0), 120);
    const int span = cu ? 0 : rs3 - lo;
    const int nwin = cu ? 0 : span + 8, ntot = nwin + 4, nsteps = cu ? 4 : 12;
    const int qr = r0 + (w >> 1), rs = min(max(qr - 4, 0), 120), di = rs - lo;
    const size_t qrow0 = cu ? (size_t)(ML + b * 256 + 32 * w) : (size_t)(b * SEQ + qr * 64 + 32 * gh);
    LAS float* rpb = (LAS float*)(F.lds + AT_RPB);
    __syncthreads();
    if (!cu) for (int i = F.tid; i < 465; i += NT) rpb[i] = 1.4426950408889634f * F.in[I_RPB][((size_t)l * 8 + h) * 465 + i];
    bf16x8 q[2][2]; f32x4 o[2][4]; float mrun[2], lrun[2];
#pragma unroll
    for (int g = 0; g < 2; ++g) {
        mrun[g] = -1e30f; lrun[g] = 0.f;
#pragma unroll
        for (int dt = 0; dt < 4; ++dt) o[g][dt] = (f32x4){0.f, 0.f, 0.f, 0.f};
#pragma unroll
        for (int kb = 0; kb < 2; ++kb) q[g][kb] = *(const bf16x8*)(F.P + (qrow0 + 16 * g + fr) * LDP + PQ + h * 64 + 32 * kb + 8 * fq);
    }
    const int srow = F.tid >> 3, sch = F.tid & 7;
#define AT_ROWBASE(x) (((x) < nwin) ? (size_t)(b * SEQ + (lo + (x)) * 64) : (size_t)(ML + b * 256 + 64 * ((x) - nwin)))
#define AT_SLOT(x) ((x) - 5 * (((x) * 13) >> 6))
#define AT_LOADX(kr_, vr_, x) do { const size_t rb0 = AT_ROWBASE(x); \
        kr_ = *(const u32x4*)(F.P + (rb0 + srow) * LDP + PK + h * 64 + sch * 8); vr_ = *(const u32x4*)(F.VT + (size_t)(h * 64 + srow) * M + rb0 + sch * 8); } while (0)
#define AT_WRITEX(kr_, vr_, x) do { LAS unsigned char* _d = F.lds + AT_SLOT(x) * AT_BUF + srow * AT_STR + sch * 16; *(LAS u32x4*)_d = kr_; *(LAS u32x4*)(_d + AT_TILE) = vr_; } while (0)
    {
        u32x4 k0[4], v0[4];
#pragma unroll
        for (int j = 0; j < 4; ++j) if (j <= span) AT_LOADX(k0[j], v0[j], j);
#pragma unroll
        for (int j = 0; j < 4; ++j) if (j <= span) AT_WRITEX(k0[j], v0[j], j);
    }
    __syncthreads();
    u32x4 kreg, vreg;
    for (int t = 0; t < nsteps; ++t) {
        const int xn = span + t + 1;
        if (xn < ntot) AT_LOADX(kreg, vreg, xn);
        if (!cu && t < 8) {
            const int x = di + t;
            const LAS unsigned char* kt = F.lds + AT_SLOT(x) * AT_BUF; const LAS unsigned char* vt = kt + AT_TILE;
            const int drow = (lo + x) - qr + 7;
            attn_step<false>(kt, vt, rpb, q[0], o[0], mrun[0], lrun[0], 2 * gh, drow, fr, fq); attn_step<false>(kt, vt, rpb, q[1], o[1], mrun[1], lrun[1], 2 * gh + 1, drow, fr, fq);
        } else {
            const int x = cu ? t : nwin + t - 8;
            const LAS unsigned char* kt = F.lds + AT_SLOT(x) * AT_BUF; const LAS unsigned char* vt = kt + AT_TILE;
            attn_step<true>(kt, vt, rpb, q[0], o[0], mrun[0], lrun[0], 0, 0, fr, fq); attn_step<true>(kt, vt, rpb, q[1], o[1], mrun[1], lrun[1], 0, 0, fr, fq);
        }
        if (xn < ntot) AT_WRITEX(kreg, vreg, xn);
        __syncthreads();
    }
#undef AT_LOADX
#undef AT_WRITEX
#undef AT_SLOT
#undef AT_ROWBASE
#pragma unroll
    for (int g = 0; g < 2; ++g) {
        float lt = lrun[g]; lt += __shfl_xor(lt, 16); lt += __shfl_xor(lt, 32);
        const float inv = 1.0f / lt;
        bf16_t* op = F.ATTN + (qrow0 + 16 * g + fr) * 512 + h * 64 + 4 * fq;
#pragma unroll
        for (int dt = 0; dt < 4; ++dt) { const f32x4 v = o[g][dt] * inv; u32x2 wv; wv.x = cvt_pk_bf16(v[0], v[1]); wv.y = cvt_pk_bf16(v[2], v[3]); *(u32x2*)(op + 16 * dt) = wv; }
    }
}

constexpr int SA_ROW = 272, SA_BUF = 256 * SA_ROW;
__device__ __forceinline__ void four_stageA(Frame& F) {
    const int fr = F.lane & 15, fq = F.lane >> 4, w = F.wave;
    const bf16_t* __restrict__ C128 = F.DFT + DFT_C128 / 2; const bf16_t* __restrict__ S128 = F.DFT + DFT_S128 / 2;
    const bf16_t* __restrict__ ZAp = F.ZA; const f32x2* __restrict__ TWp = F.TW; bf16_t* __restrict__ TPp = F.TP;
    const bf16x8 sgn = (bf16x8){(short)0x8000, (short)0x8000, (short)0x8000, (short)0x8000, (short)0x8000, (short)0x8000, (short)0x8000, (short)0x8000};
    u32x4 st[8];
#define SA_LOAD(uu) do { const int _cb = (uu) & 15, _nb = ((uu) >> 4) & 7, _b = (uu) >> 7; \
        _Pragma("unroll") for (int it = 0; it < 8; ++it) { const int qd = F.tid + it * NT, rr = qd >> 4, ch = qd & 15, j = rr >> 5, cr = rr & 31; \
            st[it] = *(const u32x4*)(ZAp + ((size_t)((8 * _nb + j) * 512 + (cr >> 4) * 256 + 16 * _cb + (cr & 15)) * 512 + 128 * _b + ch * 8)); } } while (0)
#define SA_WRITE(buf) do { _Pragma("unroll") for (int it = 0; it < 8; ++it) { const int qd = F.tid + it * NT, rr = qd >> 4, ch = qd & 15; \
            *(LAS u32x4*)(F.lds + (buf) * SA_BUF + rr * SA_ROW + ch * 16) = st[it]; } } while (0)
    __syncthreads();
    if (F.bid < 512) { SA_LOAD(F.bid); SA_WRITE(0); }
    __syncthreads();
    int it_u = 0;
    for (int u = F.bid; u < 512; u += F.G, ++it_u) {
        const int cb = u & 15, nb = (u >> 4) & 7, b = u >> 7;
        const bool has_next = (u + F.G) < 512;
        if (has_next) SA_LOAD(u + F.G);
        const LAS unsigned char* zb = F.lds + (it_u & 1) * SA_BUF;
        f32x4 Tr[8], Ti[8];
#pragma unroll
        for (int j = 0; j < 8; ++j) { Tr[j] = (f32x4){0.f, 0.f, 0.f, 0.f}; Ti[j] = (f32x4){0.f, 0.f, 0.f, 0.f}; }
#pragma unroll
        for (int kk = 0; kk < 4; ++kk) {
            const bf16x8 Cf = *(const bf16x8*)(C128 + (16 * w + fr) * 128 + 32 * kk + 8 * fq);
            const bf16x8 Sf = *(const bf16x8*)(S128 + (16 * w + fr) * 128 + 32 * kk + 8 * fq);
            const bf16x8 nSf = Sf ^ sgn;
#pragma unroll
            for (int j = 0; j < 8; ++j) {
                const bf16x8 Zr = *(const LAS bf16x8*)(zb + (j * 32 + fr) * SA_ROW + (32 * kk + 8 * fq) * 2);
                const bf16x8 Zi = *(const LAS bf16x8*)(zb + (j * 32 + 16 + fr) * SA_ROW + (32 * kk + 8 * fq) * 2);
                Tr[j] = MFMA16(Cf, Zr, Tr[j]); Tr[j] = MFMA16(Sf, Zi, Tr[j]); Ti[j] = MFMA16(Cf, Zi, Ti[j]); Ti[j] = MFMA16(nSf, Zr, Ti[j]);
            }
        }
#pragma unroll
        for (int r = 0; r < 4; ++r) {
            const int k1 = 16 * w + 4 * fq + r;
            float tr[8], ti[8];
#pragma unroll
            for (int j = 0; j < 8; ++j) { const f32x2 t = TWp[k1 * (8 * nb + j)]; tr[j] = Tr[j][r] * t.x + Ti[j][r] * t.y; ti[j] = Ti[j][r] * t.x - Tr[j][r] * t.y; }
            bf16_t* tp = TPp + ((size_t)((b * 128 + k1) * 2) * 256 + 16 * cb + fr) * 64 + 8 * nb;
            u32x4 wv; wv.x = cvt_pk_bf16(tr[0], tr[1]); wv.y = cvt_pk_bf16(tr[2], tr[3]); wv.z = cvt_pk_bf16(tr[4], tr[5]); wv.w = cvt_pk_bf16(tr[6], tr[7]);
            *(u32x4*)tp = wv;
            wv.x = cvt_pk_bf16(ti[0], ti[1]); wv.y = cvt_pk_bf16(ti[2], ti[3]); wv.z = cvt_pk_bf16(ti[4], ti[5]); wv.w = cvt_pk_bf16(ti[6], ti[7]);
            *(u32x4*)(tp + 256 * 64) = wv;
        }
        if (has_next) SA_WRITE((it_u + 1) & 1);
        __syncthreads();
    }
#undef SA_LOAD
#undef SA_WRITE
}
__device__ __forceinline__ void four_stageB(Frame& F) {
    const int gw = F.bid * NWAVES + F.wave, NGW = F.G * NWAVES, fr = F.lane & 15, fq = F.lane >> 4;
    const bf16_t* __restrict__ G64 = F.DFT + DFT_C64 / 2;
    const bf16_t* __restrict__ G256 = F.DFT + DFT_C256 / 2;
    const bf16_t* __restrict__ TPr = F.TP; const bf16_t* __restrict__ ZCr = F.ZC; bf16_t* __restrict__ FO = F.FOURO;
    {
        bf16x8 Bf[2][2][4];
#pragma unroll
        for (int ri = 0; ri < 2; ++ri)
#pragma unroll
            for (int kk = 0; kk < 2; ++kk)
#pragma unroll
                for (int t = 0; t < 4; ++t) Bf[ri][kk][t] = *(const bf16x8*)(G64 + ri * 4096 + (16 * t + fr) * 64 + 32 * kk + 8 * fq);
        for (int u = gw; u < 8192; u += NGW) {
            const int cb = u & 15, inst = u >> 4, b = inst >> 7, k1 = inst & 127;
            bf16x8 A[2][2];
#pragma unroll
            for (int ri = 0; ri < 2; ++ri)
#pragma unroll
                for (int kk = 0; kk < 2; ++kk) A[ri][kk] = __builtin_nontemporal_load((const bf16x8*)(TPr + ((size_t)(inst * 2 + ri) * 256 + 16 * cb + fr) * 64 + 32 * kk + 8 * fq));
            f32x4 acc[4];
#pragma unroll
            for (int t = 0; t < 4; ++t) acc[t] = (f32x4){0.f, 0.f, 0.f, 0.f};
#pragma unroll
            for (int ri = 0; ri < 2; ++ri)
#pragma unroll
                for (int kk = 0; kk < 2; ++kk)
#pragma unroll
                    for (int t = 0; t < 4; ++t) acc[t] = MFMA16(A[ri][kk], Bf[ri][kk][t], acc[t]);
            const float sc = 0.011048543456039806f;
#pragma unroll
            for (int t = 0; t < 4; ++t) {
                const f32x4 v = acc[t] * sc; u32x2 wv; wv.x = cvt_pk_bf16(v[0], v[1]); wv.y = cvt_pk_bf16(v[2], v[3]);
                *(u32x2*)(FO + (size_t)(b * SEQ + k1 + 128 * (16 * t + fr)) * 256 + 16 * cb + 4 * fq) = wv;
            }
        }
    }
    for (int u = gw; u < 1024; u += NGW) {
        const int kt = u & 15, cb = (u >> 4) & 15, b = u >> 8;
        bf16x8 A[2][8], B[2][8];
#pragma unroll
        for (int ri = 0; ri < 2; ++ri)
#pragma unroll
            for (int kk = 0; kk < 8; ++kk) {
                A[ri][kk] = *(const bf16x8*)(ZCr + (size_t)(ri * 256 + 16 * cb + fr) * 1024 + b * 256 + 32 * kk + 8 * fq);
                B[ri][kk] = *(const bf16x8*)(G256 + ri * 65536 + (16 * kt + fr) * 256 + 32 * kk + 8 * fq);
            }
        f32x4 acc = (f32x4){0.f, 0.f, 0.f, 0.f};
#pragma unroll
        for (int ri = 0; ri < 2; ++ri)
#pragma unroll
            for (int kk = 0; kk < 8; ++kk) acc = MFMA16(A[ri][kk], B[ri][kk], acc);
        const f32x4 v = acc * 0.0625f; u32x2 wv; wv.x = cvt_pk_bf16(v[0], v[1]); wv.y = cvt_pk_bf16(v[2], v[3]);
        *(u32x2*)(FO + (size_t)(ML + b * 256 + 16 * kt + fr) * 256 + 16 * cb + 4 * fq) = wv;
    }
}

constexpr int PL_DSTR = 264;
template <int GI>
__device__ __forceinline__ void pool_diffs(const LAS float* us, LAS bf16_t* db, int ch, int half, int R0, int S0, int S1) {
    constexpr int LO = 1 << GI, HI = LO - 1;
    float v[47];
#pragma unroll
    for (int i = 0; i < 47; ++i) v[i] = us[(half * 32 + i) * 256 + ch];
    float s = 0.f;
#pragma unroll
    for (int i = 8 - LO; i <= 8 + HI; ++i) s += v[i];
#pragma unroll
    for (int tt = 0; tt < 32; ++tt) {
        if (tt > 0) s += v[tt + 8 + HI] - v[tt + 7 - LO];
        const int row = R0 + half * 32 + tt;
        const int a = max(row - LO, S0), e = min(row + HI + 1, S1);
        db[(half * 32 + tt) * PL_DSTR + ch] = f2bf(s * __builtin_amdgcn_rcpf((float)(e - a)) - v[tt + 8]);
    }
}
__device__ __forceinline__ void pool_tiles(Frame& F, int l) {
    LAS float* us = (LAS float*)F.lds; LAS bf16_t* db = (LAS bf16_t*)(F.lds + 79 * 256 * 4);
    const int ch = F.tid & 255, half = F.tid >> 8, g = F.wave & 3, fr = F.lane & 15, fq = F.lane >> 4;
    bf16x8 wf[4][2];
    { const float* wp = F.in[I_WPOOL] + (size_t)(l * 4 + g) * 64 * 64;
#pragma unroll
      for (int nt = 0; nt < 4; ++nt)
#pragma unroll
        for (int kb = 0; kb < 2; ++kb) {
            u32x4 w;
            w.x = cvt_pk_bf16(wp[(32 * kb + 8 * fq + 0) * 64 + 16 * nt + fr], wp[(32 * kb + 8 * fq + 1) * 64 + 16 * nt + fr]);
            w.y = cvt_pk_bf16(wp[(32 * kb + 8 * fq + 2) * 64 + 16 * nt + fr], wp[(32 * kb + 8 * fq + 3) * 64 + 16 * nt + fr]);
            w.z = cvt_pk_bf16(wp[(32 * kb + 8 * fq + 4) * 64 + 16 * nt + fr], wp[(32 * kb + 8 * fq + 5) * 64 + 16 * nt + fr]);
            w.w = cvt_pk_bf16(wp[(32 * kb + 8 * fq + 6) * 64 + 16 * nt + fr], wp[(32 * kb + 8 * fq + 7) * 64 + 16 * nt + fr]);
            wf[nt][kb] = __builtin_bit_cast(bf16x8, w);
        } }
    f32x4 psc[4];
#pragma unroll
    for (int nt = 0; nt < 4; ++nt) psc[nt] = *(const f32x4*)(F.in[I_PSCALE] + l * 256 + g * 64 + 16 * nt + 4 * fq);
    u32x4 pv[5];
#define POOL_LOAD(tl) do { const int _R0 = (tl) * 64; const int _S0 = (_R0 < ML) ? (_R0 & ~(SEQ - 1)) : (ML + ((_R0 - ML) & ~(CTXL - 1))); const int _S1 = _S0 + ((_R0 < ML) ? SEQ : CTXL); \
        _Pragma("unroll") for (int it = 0; it < 5; ++it) { const int i = F.tid + it * NT, rr = i >> 5, c8 = (i & 31) * 8, row = _R0 - 8 + rr; pv[it] = (u32x4){0u, 0u, 0u, 0u}; \
            if (i < 79 * 32 && row >= _S0 && row < _S1) pv[it] = __builtin_nontemporal_load((const u32x4*)(F.P + (size_t)row * LDP + PPOOL + c8)); } } while (0)
    if (F.G - 1 - F.bid < M / 64) POOL_LOAD(F.G - 1 - F.bid);
    for (int tile = F.G - 1 - F.bid; tile < M / 64; tile += F.G) {
        const int R0 = tile * 64;
        const int S0 = (R0 < ML) ? (R0 & ~(SEQ - 1)) : (ML + ((R0 - ML) & ~(CTXL - 1)));
        const int S1 = S0 + ((R0 < ML) ? SEQ : CTXL);
        __syncthreads();
#pragma unroll
        for (int it = 0; it < 5; ++it) {
            const int i = F.tid + it * NT, rr = i >> 5, c8 = (i & 31) * 8;
            if (i < 79 * 32) {
                LAS f32x4* d = (LAS f32x4*)(us + rr * 256 + c8);
                d[0] = (f32x4){bflo(pv[it].x), bfhi(pv[it].x), bflo(pv[it].y), bfhi(pv[it].y)}; d[1] = (f32x4){bflo(pv[it].z), bfhi(pv[it].z), bflo(pv[it].w), bfhi(pv[it].w)};
            }
        }
        if (tile + F.G < M / 64) POOL_LOAD(tile + F.G);
        __syncthreads();
        if (g == 0) pool_diffs<0>(us, db, ch, half, R0, S0, S1);
        else if (g == 1) pool_diffs<1>(us, db, ch, half, R0, S0, S1);
        else if (g == 2) pool_diffs<2>(us, db, ch, half, R0, S0, S1);
        else pool_diffs<3>(us, db, ch, half, R0, S0, S1);
        __syncthreads();
#pragma unroll
        for (int mt = 0; mt < 2; ++mt) {
            bf16x8 df[2];
#pragma unroll
            for (int kb = 0; kb < 2; ++kb) df[kb] = *(const LAS bf16x8*)(db + (half * 32 + 16 * mt + fr) * PL_DSTR + g * 64 + 32 * kb + 8 * fq);
#pragma unroll
            for (int nt = 0; nt < 4; ++nt) {
                f32x4 acc = (f32x4){0.f, 0.f, 0.f, 0.f};
                acc = MFMA16(wf[nt][0], df[0], acc); acc = MFMA16(wf[nt][1], df[1], acc);
                acc *= psc[nt];
                u32x2 wv; wv.x = cvt_pk_bf16(acc[0], acc[1]); wv.y = cvt_pk_bf16(acc[2], acc[3]);
                *(u32x2*)(F.POOLO + (size_t)(R0 + half * 32 + 16 * mt + fr) * 256 + g * 64 + 16 * nt + 4 * fq) = wv;
            }
        }
    }
#undef POOL_LOAD
}

__device__ __forceinline__ void conv_tiles(Frame& F, int l) {
    LAS float* zs = (LAS float*)F.lds; LAS float* ys = (LAS float*)(F.lds + 62 * 256 * 4);
    const int ch = F.tid & 255, half = F.tid >> 8;
    float wk[31];
#pragma unroll
    for (int j = 0; j < 31; ++j) wk[j] = F.in[I_WDW][((size_t)l * 31 + j) * 256 + ch];
    const float bdw = F.in[I_BDW][l * 256 + ch];
    const f32x4 lg = *(const f32x4*)(F.in[I_LNG] + l * 256 + 4 * F.lane), lb = *(const f32x4*)(F.in[I_LNB] + l * 256 + 4 * F.lane);
    u32x4 av[4], gv[4];
#define CONV_LOAD(tl) do { const int _R0 = (tl) * 32; const int _S0 = (_R0 < ML) ? (_R0 & ~(SEQ - 1)) : (ML + ((_R0 - ML) & ~(CTXL - 1))); const int _S1 = _S0 + ((_R0 < ML) ? SEQ : CTXL); \
        _Pragma("unroll") for (int it = 0; it < 4; ++it) { const int i = F.tid + it * NT, rr = i >> 5, c8 = (i & 31) * 8, row = _R0 - 15 + rr; av[it] = (u32x4){0u, 0u, 0u, 0u}; gv[it] = (u32x4){0u, 0u, 0u, 0u}; \
            if (i < 62 * 32 && row >= _S0 && row < _S1) { av[it] = __builtin_nontemporal_load((const u32x4*)(F.P + (size_t)row * LDP + PCA + c8)); gv[it] = __builtin_nontemporal_load((const u32x4*)(F.P + (size_t)row * LDP + PCG + c8)); } } } while (0)
    const int vbc = ((F.G & 7) == 0) ? (F.bid & 7) * (F.G >> 3) + (F.bid >> 3) : F.bid;
    if (vbc < M / 32) CONV_LOAD(vbc);
    for (int tile = vbc; tile < M / 32; tile += F.G) {
        const int R0 = tile * 32;
        __syncthreads();
#pragma unroll
        for (int it = 0; it < 4; ++it) {
            const int i = F.tid + it * NT, rr = i >> 5, c8 = (i & 31) * 8;
            if (i < 62 * 32) {
                const u32x4 a = av[it], gq = gv[it];
                LAS f32x4* d = (LAS f32x4*)(zs + rr * 256 + c8);
                d[0] = (f32x4){bflo(a.x) * sigmoidf_(bflo(gq.x)), bfhi(a.x) * sigmoidf_(bfhi(gq.x)), bflo(a.y) * sigmoidf_(bflo(gq.y)), bfhi(a.y) * sigmoidf_(bfhi(gq.y))};
                d[1] = (f32x4){bflo(a.z) * sigmoidf_(bflo(gq.z)), bfhi(a.z) * sigmoidf_(bfhi(gq.z)), bflo(a.w) * sigmoidf_(bflo(gq.w)), bfhi(a.w) * sigmoidf_(bfhi(gq.w))};
            }
        }
        if (tile + F.G < M / 32) CONV_LOAD(tile + F.G);
        __syncthreads();
        {
            float acc[16];
#pragma unroll
            for (int t = 0; t < 16; ++t) acc[t] = bdw;
            float zv[46];
#pragma unroll
            for (int i = 0; i < 46; ++i) zv[i] = zs[(half * 16 + i) * 256 + ch];
#pragma unroll
            for (int i = 0; i < 46; ++i) {
#pragma unroll
                for (int t = 0; t < 16; ++t) { const int j = i - t; if (j >= 0 && j < 31) acc[t] += zv[i] * wk[j]; }
            }
#pragma unroll
            for (int t = 0; t < 16; ++t) ys[(half * 16 + t) * 256 + ch] = acc[t];
        }
        __syncthreads();
#pragma unroll
        for (int q = 0; q < 4; ++q) {
            const int t = F.wave * 4 + q;
            const f32x4 v = *(const LAS f32x4*)(ys + t * 256 + 4 * F.lane);
            const float mu = wave_sum((v.x + v.y) + (v.z + v.w)) * (1.0f / 256.0f);
            const f32x4 dv = v - mu;
            const float var = wave_sum((dv.x * dv.x + dv.y * dv.y) + (dv.z * dv.z + dv.w * dv.w)) * (1.0f / 256.0f);
            const float rstd = 1.0f / sqrtf(var + 1e-6f);
            f32x4 o = dv * rstd * lg + lb;
            o.x = o.x * sigmoidf_(o.x); o.y = o.y * sigmoidf_(o.y); o.z = o.z * sigmoidf_(o.z); o.w = o.w * sigmoidf_(o.w);
            u32x2 wv; wv.x = cvt_pk_bf16(o.x, o.y); wv.y = cvt_pk_bf16(o.z, o.w);
            *(u32x2*)(F.CONVO + (size_t)(R0 + t) * 256 + 4 * F.lane) = wv;
        }
    }
}

__device__ __forceinline__ void zero_fill(Frame& F, bf16_t* p, size_t nelem) { u32x4* q = (u32x4*)p; const size_t n = nelem / 8; for (size_t i = (size_t)F.bid * NT + F.tid; i < n; i += (size_t)F.G * NT) q[i] = (u32x4){0u, 0u, 0u, 0u}; }

#define XB_TMO      128
#define XB_XCNT(j)  (256  + 64 * (j))
#define XB_XSUB(j)  (1280 + 64 * (j))
#define XB_XGEN(j)  (2304 + 64 * (j))
#define XB_TOP      3328
#define XB_TOPGEN   3392
#define XCD_BAR_WORDS 3456
#define XB_SPIN_CAP (1u << 22)
__device__ __forceinline__ unsigned xb_ld(unsigned* p)              { return __hip_atomic_load(p, __ATOMIC_RELAXED, __HIP_MEMORY_SCOPE_AGENT); }
__device__ __forceinline__ unsigned xb_add(unsigned* p, unsigned v) { return __hip_atomic_fetch_add(p, v, __ATOMIC_RELAXED, __HIP_MEMORY_SCOPE_AGENT); }
__device__ __forceinline__ unsigned xb_xcc_id() { return (unsigned)__builtin_amdgcn_s_getreg((3 << 11) | 20) & 0xFu; }
#define XB_SPIN(cond, bar) do { unsigned _sp = 0; while (cond) { __builtin_amdgcn_s_sleep(1); \
    if ((++_sp & 255u) == 0u) { if (xb_ld(&(bar)[XB_TMO])) break; if (_sp > XB_SPIN_CAP) { atomicAdd(&(bar)[XB_TMO], 1u); break; } } } } while (0)
__device__ __forceinline__ void xcd_barrier_complete(unsigned* bar, unsigned x, unsigned& nloc, unsigned& nx) {
    const unsigned G = gridDim.x * gridDim.y * gridDim.z;
    unsigned sum, cnt, mine, sp = 0u;
    for (;;) {
        sum = 0u; cnt = 0u; mine = 0u;
#pragma unroll
        for (unsigned j = 0; j < 16; ++j) { const unsigned c = xb_ld(&bar[XB_XCNT(j)]); sum += c; cnt += (c > 0u) ? 1u : 0u; mine = (j == x) ? c : mine; }
        if (sum == G) break;
        __builtin_amdgcn_s_sleep(1);
        if ((++sp & 255u) == 0u) { if (xb_ld(&bar[XB_TMO])) break; if (sp > XB_SPIN_CAP) { atomicAdd(&bar[XB_TMO], 1u); break; } }
    }
    nloc = mine > 0u ? mine : 1u; nx = cnt > 0u ? cnt : 1u;
}
__device__ __forceinline__ void xcd_barrier(unsigned* bar, volatile LAS unsigned* st) {
    asm volatile("s_waitcnt vmcnt(0)" ::: "memory");
    __syncthreads();
    if (threadIdx.x == 0) {
        __builtin_amdgcn_s_waitcnt(0);
        const unsigned x = xb_xcc_id();
        unsigned nloc = st[0], nx = st[1];
        if (nloc == 0u) { xcd_barrier_complete(bar, x, nloc, nx); st[0] = nloc; st[1] = nx; }
        const unsigned old = xb_add(&bar[XB_XSUB(x)], 1u);
        const unsigned gen = old / nloc;
        if (old + 1u == (gen + 1u) * nloc) {
            __builtin_amdgcn_fence(__ATOMIC_RELEASE, "agent");
            asm volatile("s_waitcnt vmcnt(0)" ::: "memory");
            const unsigned og = xb_add(&bar[XB_TOP], 1u);
            const unsigned tg = og / nx;
            if (og + 1u == (tg + 1u) * nx) xb_add(&bar[XB_TOPGEN], 1u);
            else XB_SPIN(xb_ld(&bar[XB_TOPGEN]) == tg, bar);
            __builtin_amdgcn_fence(__ATOMIC_ACQUIRE, "agent");
            xb_add(&bar[XB_XGEN(x)], 1u);
            asm volatile("s_waitcnt vmcnt(0)" ::: "memory");
        } else {
            XB_SPIN(xb_ld(&bar[XB_XGEN(x)]) == gen, bar);
            __builtin_amdgcn_fence(__ATOMIC_ACQUIRE, "agent");
            asm volatile("s_waitcnt vmcnt(0)" ::: "memory");
        }
    }
    __syncthreads();
}
constexpr size_t WS_BAR = 2 * MiB + 768 * 1024;
constexpr int LDS_BARST = LDS_BYTES - 64;
__device__ __forceinline__ void build_frame(Frame& F, unsigned char* lds_raw) {
    int t = threadIdx.x; asm volatile("" : "+v"(t));
    unsigned long long ka = (unsigned long long)__builtin_amdgcn_kernarg_segment_ptr(); asm volatile("" : "+s"(ka));
    F.lds = (LAS unsigned char*)lds_raw;
    F.tid = t; F.lane = t & 63; F.wave = __builtin_amdgcn_readfirstlane(t >> 6); F.G = gridDim.x; F.bid = blockIdx.x;
    F.in = (const KAS cfp*)ka; F.out = *(float* const KAS*)(ka + 192); unsigned char* ws = *(unsigned char* const KAS*)(ka + 200); F.ws = ws;
    F.MOD = (float*)(ws + WS_MOD); F.ROPE = (const f32x2*)(ws + WS_ROPE); F.TW = (const f32x2*)(ws + WS_TW); F.DFT = (const bf16_t*)(ws + WS_DFT); F.XC = (float*)(ws + WS_XC);
    F.WT = (bf16_t*)(ws + WS_WT); F.H = (bf16_t*)F.out; F.XB = (bf16_t*)(ws + WS_XB);
    F.P = (bf16_t*)(ws + WS_R1 + R1_P); F.VT = (bf16_t*)(ws + WS_R1 + R1_VT); F.ZA = (bf16_t*)(ws + WS_R1 + R1_ZA); F.ZC = (bf16_t*)(ws + WS_R1 + R1_ZC); F.TP = (bf16_t*)(ws + WS_R1 + R1_TP);
    F.Y = (bf16_t*)(ws + WS_R1); F.U = (bf16_t*)(ws + WS_R1);
    F.ATTN = (bf16_t*)(ws + WS_R2 + R2_ATTN); F.POOLO = (bf16_t*)(ws + WS_R2 + R2_POOL); F.FOURO = (bf16_t*)(ws + WS_R2 + R2_FOUR); F.CONVO = (bf16_t*)(ws + WS_R2 + R2_CONV);
    F.MERGED = (bf16_t*)(ws + WS_R1 + R1_MG);
}
static_assert(sizeof(Args) == 216 && offsetof(Args, out) == 192 && offsetof(Args, ws) == 200, "kernarg layout");
constexpr int PH_PER_LAYER = 10, NPH = 1 + NL * PH_PER_LAYER + 1;
__global__ void __launch_bounds__(NT, 2) fwd_kernel(Args args) {
    extern __shared__ __attribute__((aligned(16))) unsigned char lds_raw[];
    const int lo = args.ph_lo, hi = args.ph_hi;
#define IN(k) (lo <= (k) && (k) < hi)
#define INP(j) (IN(p0 + (j)) && PHON(j))
#define XL_IN ((l == 0) ? F.in[I_X] : (const float*)nullptr)
#define XC_IN ((l == 0) ? F.in[I_CTX] : F.XC)
#define PB6 ((float*)((unsigned char*)F.out + OUT_PB6))
#define PB9 ((float*)(F.ws + WS_R2))
#define Hc ((const char*)F.H)
#define WTc ((const char*)F.WT)
#define SEAM(k) do { if (IN(k) && IN((k) + 1)) { xcd_barrier(xbar, xst); } } while (0)
    unsigned* xbar = (unsigned*)(args.ws + WS_BAR); volatile LAS unsigned* xst = (volatile LAS unsigned*)((LAS unsigned char*)lds_raw + LDS_BARST);
    if (threadIdx.x == 0) { xst[0] = 0u; xst[1] = 0u; }
    if (lo == 0 && hi > 1) {
        if (blockIdx.x == 0) for (int i = threadIdx.x; i < XCD_BAR_WORDS; i += NT) __hip_atomic_store(xbar + i, 0u, __ATOMIC_RELAXED, __HIP_MEMORY_SCOPE_AGENT);
        cg::this_grid().sync();
        if (threadIdx.x == 0) (void)xb_add(&xbar[XB_XCNT(xb_xcc_id())], 1u);
    }
    __syncthreads();
    if (IN(0) && PHON(10)) { Frame F; build_frame(F, lds_raw); p0_prologue(F);
#ifdef SCRUB
        { u32x4* p = (u32x4*)(F.ws + WS_XB); const size_t n = (WS_END - WS_XB) / 16; for (size_t i = (size_t)F.bid * NT + F.tid; i < n; i += (size_t)F.G * NT) p[i] = (u32x4){0xAAAAAAAAu, 0xAAAAAAAAu, 0xAAAAAAAAu, 0xAAAAAAAAu}; }
#endif
    }
    SEAM(0);
    for (int l = 0; l < NL; ++l) {
        const int p0 = 1 + l * PH_PER_LAYER;
        const bool lastl = (l == NL - 1);
        const int nMr = lastl ? 128 : 132;
        if (INP(0)) for (int rep = 0; rep < NREP(0); ++rep) { Frame F; build_frame(F, lds_raw); norm_mod_rows(F, l, XL_IN, XC_IN, F.XC, PB9, (l == 0 || rep > 0) ? 0 : 16, (l == 0) ? nullptr : mod_ptr(F, l - 1, 4, 5), F.in[I_GMIX] + l * D, 0, 1, M); __syncthreads(); convert_weights(F, l); }
        SEAM(p0 + 0);
        if (INP(1)) for (int rep = 0; rep < NREP(1); ++rep) { Frame F; build_frame(F, lds_raw);
            __syncthreads();
            { Order1 S{F.G, F.bid, Hc, WTc, lastl ? 0 : 64}; Epi1 E{F.P, F.VT, F.ZC, F.ROPE, (bf16_t*)(F.ws + WS_R1 + R1_GC)}; pg8::gemm_phase(F.lds, F.tid, S, E); }
            { Order2 S{F.G, F.bid, Hc, WTc}; EpiPlain E{F.ZA, 512, (size_t)512 * 512, 0}; pg8::gemm_phase(F.lds, F.tid, S, E); }
        }
        SEAM(p0 + 1);
        if (INP(2)) for (int rep = 0; rep < NREP(2); ++rep) { Frame F; build_frame(F, lds_raw);
            const int nunits = 1024 + (lastl ? 0 : 32);
#if !(EXPM & 1)
            const int vb = ((F.G & 7) == 0) ? (F.bid & 7) * (F.G >> 3) + (F.bid >> 3) : F.bid;
            for (int u = vb; u < nunits; u += F.G) {
                if (u < 1024) { const int rb = u & 31, h = (u >> 5) & 7, b = u >> 8; attn_unit(F, l, b, h, rb); }
                else { const int v = u - 1024; attn_unit(F, l, v >> 3, v & 7, -1); }
            }
#endif
#if !(EXPM & 2)
            four_stageA(F); if (REP2 & 8) four_stageA(F);
#endif
            if (EXPM & 1) zero_fill(F, F.ATTN, (size_t)M * 512);
        }
        SEAM(p0 + 2);
        if (INP(3)) for (int rep = 0; rep < NREP(3); ++rep) { Frame F; build_frame(F, lds_raw); __syncthreads();
            if (EXPM & 4) zero_fill(F, F.POOLO, (size_t)M * 256); else { pool_tiles(F, l); if (REP2 & 1) { __syncthreads(); pool_tiles(F, l); } }
            __syncthreads();
            if (EXPM & 8) zero_fill(F, F.CONVO, (size_t)M * 256); else { conv_tiles(F, l); if (REP2 & 2) { __syncthreads(); conv_tiles(F, l); } }
            if (EXPM & 2) zero_fill(F, F.FOURO, (size_t)M * 256); else four_stageB(F); }
        SEAM(p0 + 3);
        if (INP(5)) for (int rep = 0; rep < NREP(5); ++rep) { Frame F; build_frame(F, lds_raw); __syncthreads();
            OrderF S{F.G, F.bid, lastl ? 0 : 64, Hc, WTc, (const char*)(F.ws + WS_R2)};
            EpiFused E{F.MERGED, (bf16_t*)(F.ws + WS_R1 + R1_GYC), F.ws + WS_R1 + R1_YSCR + (size_t)F.bid * 131072, (const bf16_t*)(F.ws + WS_R1 + R1_GC)};
            pg8::gemm_phase(F.lds, F.tid, S, E); }
        SEAM(p0 + 5);
        if (INP(6)) for (int rep = 0; rep < NREP(6); ++rep) { Frame F; build_frame(F, lds_raw); __syncthreads();
            { OrderN S{F.G, F.bid, 128, 4, 1, 1024, 1024, (const char*)F.MERGED, WTc + WT_O * 2, 0, 0}; EpiRes E{F.XB, F.MOD + (size_t)l * 5 * 6144, 2}; pg8::gemm_phase(F.lds, F.tid, S, E); }
            if (!lastl) { OrderMini S{F.G, F.bid, 8, 512, 4096, 1024, 1024, (const char*)(F.ws + WS_R1 + R1_GYC), WTc + WT_O * 2}; EpiPartial E{PB6}; pg8::gemm_phase(F.lds, F.tid, S, E); }
        }
        SEAM(p0 + 6);
        if (INP(7)) for (int rep = 0; rep < NREP(7); ++rep) { Frame F; build_frame(F, lds_raw); norm_mod_rows(F, l, nullptr, F.XC, F.XC, PB6, (rep > 0) ? 0 : 8, mod_ptr(F, l, 4, 2), F.in[I_GFF] + l * D, 3, 4, lastl ? ML : M); }
        SEAM(p0 + 7);
        if (INP(8)) for (int rep = 0; rep < NREP(8); ++rep) { Frame F; build_frame(F, lds_raw); __syncthreads(); OrderN S{F.G, F.bid, nMr, 16, 1, 1024, 1024, Hc, WTc + WT_1 * 2, 0, 0}; EpiPlain E{F.U, 4096, 0, 1}; pg8::gemm_phase(F.lds, F.tid, S, E); }
        SEAM(p0 + 8);
        if (INP(9)) for (int rep = 0; rep < NREP(9); ++rep) { Frame F; build_frame(F, lds_raw); __syncthreads();
            { OrderN S{F.G, F.bid, 128, 4, 1, 4096, 4096, (const char*)F.U, WTc + WT_2 * 2, 0, 0}; EpiRes E{F.XB, F.MOD + (size_t)l * 5 * 6144, 5}; pg8::gemm_phase(F.lds, F.tid, S, E); }
            if (!lastl) { OrderMini S{F.G, F.bid, 16, 256, 4096, 4096, 4096, (const char*)(F.U + (size_t)ML * 4096), WTc + WT_2 * 2}; EpiPartial E{PB9}; pg8::gemm_phase(F.lds, F.tid, S, E); }
        }
        SEAM(p0 + 9);
    }
    if (IN(NPH - 1) && PHON(11)) { Frame F; build_frame(F, lds_raw); final_norm(F); }
#undef IN
#undef SEAM
}

extern "C" void kernel_launch(void* const* d_in, const int* in_sizes, int n_in, void* d_out, int out_size, void* d_ws, size_t ws_size, hipStream_t stream) {
    static int grid = 0;
    if (grid == 0) {
        if (n_in != 24 || out_size != ML * D || ws_size < WS_END) { fprintf(stderr, "kernel_launch: unexpected shapes (n_in %d out %d ws %zu)\n", n_in, out_size, ws_size); grid = -1; return; }
        int dev = 0, cus = 0, per_cu = 0;
        hipGetDevice(&dev); hipDeviceGetAttribute(&cus, hipDeviceAttributeMultiprocessorCount, dev);
        if (hipFuncSetAttribute((const void*)fwd_kernel, hipFuncAttributeMaxDynamicSharedMemorySize, LDS_BYTES) != hipSuccess) { fprintf(stderr, "kernel_launch: hipFuncSetAttribute failed\n"); grid = -1; return; }
        if (hipOccupancyMaxActiveBlocksPerMultiprocessor(&per_cu, (const void*)fwd_kernel, NT, LDS_BYTES) != hipSuccess || per_cu < 1) { fprintf(stderr, "kernel_launch: occupancy query says %d\n", per_cu); per_cu = 1; }
        (void)hipGetLastError();
        grid = cus * 1;
    }
    if (grid < 0) return;
    Args a{};
    for (int i = 0; i < 24; ++i) a.in[i] = (const float*)d_in[i];
    a.out = (float*)d_out; a.ws = (unsigned char*)d_ws;
#if MK_ONE_LAUNCH
    a.ph_lo = 0; a.ph_hi = NPH;
    void* kargs[] = {&a};
    hipError_t e = hipLaunchCooperativeKernel((const void*)fwd_kernel, dim3(grid), dim3(NT), kargs, LDS_BYTES, stream);
    if (e != hipSuccess) fprintf(stderr, "cooperative launch failed: %s (grid %d)\n", hipGetErrorString(e), grid);
#else
    for (int p = 0; p < NPH; ++p) { a.ph_lo = p; a.ph_hi = p + 1; hipLaunchKernelGGL(fwd_kernel, dim3(grid), dim3(NT), LDS_BYTES, stream, a); }
#endif
}
```
